# Optimizing an MI355X kernel written in HIP

```python
import jax, jax.numpy as jnp
from jax import lax
import numpy as np

D_MODEL = 2048
BATCH = 4
SEQ = 4096
DEPTH = 1

GLA_WIDTH = D_MODEL // 2
ATT_WIDTH = D_MODEL - GLA_WIDTH
MIX_WIDTH = GLA_WIDTH + ATT_WIDTH

GLA_HEADS = 4
GLA_DV = GLA_WIDTH // GLA_HEADS
GLA_DK = GLA_DV // 2
GLA_QK = GLA_HEADS * GLA_DK
GLA_GATE_RANK = 16
GLA_GATE_TAU = 16.0
GLA_CHUNK = 64

ATT_HD = 128
ATT_HEADS = ATT_WIDTH // ATT_HD
DIL_CONFIGS = ((128, 1), (512, 4), (2048, 16))
ATT_BLOCK = 128
ROPE_THETA = 10000.0

D_FF = 5632
FFN_RESIDUAL_WEIGHT = 0.5
EPS = 1e-6

IN_SIZES = (GLA_QK, GLA_QK, GLA_WIDTH, GLA_GATE_RANK, GLA_WIDTH, ATT_WIDTH, ATT_WIDTH, ATT_WIDTH)
D_IN = sum(IN_SIZES)

kernel_name = "hymba_gla_dilated_macaron_layer"


def rms_norm(x, g):
    xf = x.astype(jnp.float32)
    y = xf * lax.rsqrt(jnp.mean(xf * xf, axis=-1, keepdims=True) + EPS)
    return (y * g.astype(jnp.float32)).astype(x.dtype)


def swiglu(x, w_gate, w_up, w_down):
    return (jax.nn.silu(x @ w_gate) * (x @ w_up)) @ w_down


def rope(x, pos):
    half = x.shape[-1] // 2
    inv_freq = 1.0 / (ROPE_THETA ** (jnp.arange(half, dtype=jnp.float32) / half))
    ang = pos.astype(jnp.float32)[:, None] * inv_freq[None, :]
    cos = jnp.cos(ang)[None, :, None, :]
    sin = jnp.sin(ang)[None, :, None, :]
    xf = x.astype(jnp.float32)
    x1, x2 = xf[..., :half], xf[..., half:]
    out = jnp.concatenate([x1 * cos - x2 * sin, x2 * cos + x1 * sin], axis=-1)
    return out.astype(x.dtype)


def gla_chunked(q, k, v, log_a):
    B, S, H, DK = q.shape
    DV = v.shape[-1]
    C = GLA_CHUNK
    n = S // C

    def chunks(t):
        return t.astype(jnp.float32).reshape(B, n, C, H, t.shape[-1]).transpose(1, 0, 3, 2, 4)

    qc = chunks(q) * (DK ** -0.5)
    kc = chunks(k)
    vc = chunks(v)
    b = jnp.cumsum(chunks(log_a), axis=3)
    b_ref = b[:, :, :, C // 2 - 1:C // 2, :]
    b_last = b[:, :, :, C - 1:, :]

    scores = jnp.einsum('nbhid,nbhjd->nbhij', qc * jnp.exp(b - b_ref), kc * jnp.exp(b_ref - b))
    causal = jnp.tril(jnp.ones((C, C), dtype=bool))
    o_intra = jnp.einsum('nbhij,nbhjv->nbhiv', jnp.where(causal, scores, 0.0), vc)

    q_inter = qc * jnp.exp(b)
    k_state = kc * jnp.exp(b_last - b)
    decay = jnp.exp(b_last[:, :, :, 0, :])

    def step(state, xs):
        q_i, k_i, v_i, d_i = xs
        o = jnp.einsum('bhcd,bhdv->bhcv', q_i, state)
        state = d_i[..., None] * state + jnp.einsum('bhcd,bhcv->bhdv', k_i, v_i)
        return state, o

    state0 = jnp.zeros((B, H, DK, DV), jnp.float32)
    _, o_inter = lax.scan(step, state0, (q_inter, k_state, vc, decay))
    o = o_intra + o_inter
    return o.transpose(1, 0, 3, 2, 4).reshape(B, S, H, DV)


def dilated_branch(q, k, v, window, dilation):
    B, S, H, D = q.shape
    r = dilation
    L = S // r
    steps = window // dilation
    blk = ATT_BLOCK
    nb = -(-L // blk)
    Lp = nb * blk

    def to_blocks(t):
        t = t.reshape(B, L, r, H, D).transpose(0, 2, 1, 3, 4)
        t = jnp.pad(t, ((0, 0), (0, 0), (0, Lp - L), (0, 0), (0, 0)))
        return t.reshape(B, r, nb, blk, H, D)

    qb, kb, vb = to_blocks(q), to_blocks(k), to_blocks(v)

    def with_prev(t):
        prev = jnp.concatenate([jnp.zeros_like(t[:, :, :1]), t[:, :, :-1]], axis=2)
        return jnp.concatenate([prev, t], axis=3)

    kk, vv = with_prev(kb), with_prev(vb)
    s = jnp.einsum('brnqhd,brnkhd->brnhqk', qb.astype(jnp.float32), kk.astype(jnp.float32)) * (D ** -0.5)

    qi = jnp.arange(blk)[:, None] + blk
    kj = jnp.arange(2 * blk)[None, :]
    dist = qi - kj
    band = (dist >= 0) & (dist <= steps)
    first = (jnp.arange(nb) == 0)[:, None, None]
    mask = band[None] & ~(first & (kj < blk)[None])
    s = jnp.where(mask[None, None, :, None, :, :], s, -jnp.inf)

    m = jnp.max(s, axis=-1, keepdims=True)
    p = jnp.exp(s - m)
    l = jnp.sum(p, axis=-1, keepdims=True)
    o = jnp.einsum('brnhqk,brnkhd->brnqhd', p / l, vv.astype(jnp.float32))
    lse = (m + jnp.log(l))[..., 0]

    o = o.reshape(B, r, Lp, H, D)[:, :, :L].transpose(0, 2, 1, 3, 4).reshape(B, S, H, D)
    lse = lse.transpose(0, 1, 2, 4, 3).reshape(B, r, Lp, H)[:, :, :L]
    lse = lse.transpose(0, 2, 1, 3).reshape(B, S, H)
    return o, lse


def dilated_attention(q, k, v):
    outs, lses = [], []
    for window, dilation in DIL_CONFIGS:
        o_i, lse_i = dilated_branch(q, k, v, window, dilation)
        outs.append(o_i)
        lses.append(lse_i)
    w = jax.nn.softmax(jnp.stack(lses, axis=0), axis=0)
    return jnp.sum(w[..., None] * jnp.stack(outs, axis=0), axis=0)


def setup_inputs(seed: int = 0) -> dict:
    key = jax.random.key(seed)
    ks = jax.random.split(key, 20)
    f32 = jnp.float32

    def w(k_, shape, fan_in):
        return jax.random.normal(k_, shape, f32) * (fan_in ** -0.5)

    def gain(k_, n):
        return 1.0 + 0.02 * jax.random.normal(k_, (DEPTH, n), f32)

    return {
        "x": jax.random.normal(ks[0], (BATCH, SEQ, D_MODEL), f32),
        "ffn1_norm": gain(ks[1], D_MODEL),
        "ffn1_w_gate": w(ks[2], (DEPTH, D_MODEL, D_FF), D_MODEL),
        "ffn1_w_up": w(ks[3], (DEPTH, D_MODEL, D_FF), D_MODEL),
        "ffn1_w_down": w(ks[4], (DEPTH, D_FF, D_MODEL), D_FF),
        "mix_norm": gain(ks[5], D_MODEL),
        "w_in": w(ks[6], (DEPTH, D_MODEL, D_IN), D_MODEL),
        "gla_gate_up": w(ks[7], (DEPTH, GLA_GATE_RANK, GLA_QK), GLA_GATE_RANK),
        "gla_gate_bias": 0.1 * jax.random.normal(ks[8], (DEPTH, GLA_QK), f32),
        "gla_out_norm": gain(ks[9], GLA_DV),
        "att_q_norm": gain(ks[10], ATT_HD),
        "att_k_norm": gain(ks[11], ATT_HD),
        "w_out": w(ks[12], (DEPTH, MIX_WIDTH, D_MODEL), MIX_WIDTH),
        "ffn2_norm": gain(ks[13], D_MODEL),
        "ffn2_w_gate": w(ks[14], (DEPTH, D_MODEL, D_FF), D_MODEL),
        "ffn2_w_up": w(ks[15], (DEPTH, D_MODEL, D_FF), D_MODEL),
        "ffn2_w_down": w(ks[16], (DEPTH, D_FF, D_MODEL), D_FF),
    }


def reference(x, ffn1_norm, ffn1_w_gate, ffn1_w_up, ffn1_w_down, mix_norm, w_in,
              gla_gate_up, gla_gate_bias, gla_out_norm, att_q_norm, att_k_norm, w_out,
              ffn2_norm, ffn2_w_gate, ffn2_w_up, ffn2_w_down):
    B, S, _ = x.shape
    pos = jnp.arange(S)
    split_points = list(np.cumsum(IN_SIZES)[:-1])
    for l in range(DEPTH):
        x = x + FFN_RESIDUAL_WEIGHT * swiglu(rms_norm(x, ffn1_norm[l]), ffn1_w_gate[l], ffn1_w_up[l], ffn1_w_down[l])

        h = rms_norm(x, mix_norm[l])
        z = h @ w_in[l]
        q_g, k_g, v_g, g_low, r_g, q_a, k_a, v_a = jnp.split(z, split_points, axis=-1)

        gate_logit = (g_low @ gla_gate_up[l] + gla_gate_bias[l]).astype(jnp.float32)
        log_a = jax.nn.log_sigmoid(gate_logit) / GLA_GATE_TAU
        o_g = gla_chunked(q_g.reshape(B, S, GLA_HEADS, GLA_DK),
                          k_g.reshape(B, S, GLA_HEADS, GLA_DK),
                          v_g.reshape(B, S, GLA_HEADS, GLA_DV),
                          log_a.reshape(B, S, GLA_HEADS, GLA_DK))
        o_g = rms_norm(o_g, gla_out_norm[l]).reshape(B, S, GLA_WIDTH)
        o_g = (o_g * jax.nn.silu(r_g.astype(jnp.float32))).astype(x.dtype)

        qa = rope(rms_norm(q_a.reshape(B, S, ATT_HEADS, ATT_HD), att_q_norm[l]), pos)
        ka = rope(rms_norm(k_a.reshape(B, S, ATT_HEADS, ATT_HD), att_k_norm[l]), pos)
        va = v_a.reshape(B, S, ATT_HEADS, ATT_HD)
        o_a = dilated_attention(qa, ka, va).reshape(B, S, ATT_WIDTH).astype(x.dtype)

        x = x + jnp.concatenate([o_g, o_a], axis=-1) @ w_out[l]

        x = x + FFN_RESIDUAL_WEIGHT * swiglu(rms_norm(x, ffn2_norm[l]), ffn2_w_gate[l], ffn2_w_up[l], ffn2_w_down[l])
    return x
```

```cpp
#include <hip/hip_runtime.h>
#include <hip/hip_cooperative_groups.h>
#include <cstdio>
#include <cstdint>
namespace cg = cooperative_groups;

namespace pg8 {
#define PG8_LAS __attribute__((address_space(3)))
typedef unsigned short bf16_t;
typedef short bf16x8 __attribute__((ext_vector_type(8)));
typedef float f32x4 __attribute__((ext_vector_type(4)));
typedef unsigned u32x4 __attribute__((ext_vector_type(4)));
constexpr int BM = 256, BK = 64, HALF = 128, HTB = HALF * BK * 2  , STAGE_BYTES = 8 * HTB, NXCD = 8, WGM = 8;

__host__ __device__ __forceinline__ int lds_byte(int r, int c) { const int st = (r >> 4) * 2 + (c >> 5), rr = r & 15, cc = c & 31, ob = rr * 64 + cc * 2; return st * 1024 + (ob ^ (((ob >> 9) & 1) << 5)); }
__host__ __device__ __forceinline__ void stage_rc(int b, int& R, int& C) { const int st = b / 1024, sb = b % 1024, swz = sb ^ (((sb >> 9) & 1) << 5); R = (st >> 1) * 16 + swz / 64; C = (st & 1) * 32 + (swz % 64) / 2; }
__host__ __device__ __forceinline__ int perm32(int rho) { const int n = rho >> 4, i = rho & 15; return 8 * (i >> 2) + 4 * n + (i & 3); }

struct Unit { int pm, pn; };
struct Gemm { const bf16_t* A; const bf16_t* Bt; int M, N, K; };

struct StaticOrder {
    int nM, nN, nwg, G, c;
    __host__ __device__ void init(int M, int N, int G_, int c_) { nM = M / BM; nN = N / BM; nwg = nM * nN; G = G_; c = c_; }
    __host__ __device__ bool next(int i, Unit& u) const {
        const long L = (long)i * G + c; if (L >= nwg) return false;
        int wgid = (int)L; { const int q = nwg / NXCD, r = nwg % NXCD, xcd = wgid % NXCD, off = wgid / NXCD; wgid = (xcd < r ? xcd * (q + 1) : r * (q + 1) + (xcd - r) * q) + off; }
        const int nig = WGM * nN, gid = wgid / nig, fm = gid * WGM, gsz = (nM - fm) < WGM ? (nM - fm) : WGM;
        u.pm = fm + ((wgid % nig) % gsz); u.pn = (wgid % nig) / gsz; return true;
    }
    __device__ __forceinline__ void a_ready(const Unit&) const {}
    __device__ __forceinline__ void done(const Unit&) const {}
};

struct SplitOrder {
    int nM, nN, nwg, first, stride, count;
    __host__ __device__ void init(int M, int N, int first_, int stride_, int count_) { nM = M / BM; nN = N / BM; nwg = nM * nN; first = first_; stride = stride_; count = count_; }
    __host__ __device__ bool next(int i, Unit& u) const {
        if (i >= count) return false;
        const long L = (long)i * stride + first; if (L >= nwg) return false;
        int wgid = (int)L; { const int q = nwg / NXCD, r = nwg % NXCD, xcd = wgid % NXCD, off = wgid / NXCD; wgid = (xcd < r ? xcd * (q + 1) : r * (q + 1) + (xcd - r) * q) + off; }
        const int nig = WGM * nN, gid = wgid / nig, fm = gid * WGM, gsz = (nM - fm) < WGM ? (nM - fm) : WGM;
        u.pm = fm + ((wgid % nig) % gsz); u.pn = (wgid % nig) / gsz; return true;
    }
    __device__ __forceinline__ void a_ready(const Unit&) const {}
    __device__ __forceinline__ void done(const Unit&) const {}
};

__device__ __forceinline__ unsigned cvt_pk_bf16(float lo, float hi) { unsigned r; asm volatile("v_cvt_pk_bf16_f32 %0, %1, %2" : "=v"(r) : "v"(lo), "v"(hi)); return r; }
typedef float f32x2 __attribute__((ext_vector_type(2)));
__device__ __forceinline__ float silu_f(float g) { return g * __builtin_amdgcn_rcpf(1.0f + __builtin_amdgcn_exp2f(-1.44269504089f * g)); }

struct EpiBf16 {
    static constexpr bool PERM = true, AFTER_DRAIN = false;
    bf16_t* O; int ldc; const float* rowss; bf16_t* QKVC;
    __device__ __forceinline__ void operator()(const f32x4 (&acc)[2][2][4][2], const Unit& u, int wr, int wc, int fr, int fq) const {
        const int row0 = u.pm * BM + wr * 64 + fr; const int cw = wc * 32 + 8 * fq;
#pragma unroll
        for (int ai = 0; ai < 2; ++ai)
#pragma unroll
            for (int m = 0; m < 4; ++m) { const int row = row0 + ai * HALF + m * 16;
                const float rs = 1.0f / sqrtf(rowss[row] * (1.0f / 2048.0f) + 1e-6f);
#pragma unroll
                for (int bj = 0; bj < 2; ++bj) { const f32x4 v0 = acc[ai][bj][m][0] * rs, v1 = acc[ai][bj][m][1] * rs;
                    u32x4 w; w.x = cvt_pk_bf16(v0[0], v0[1]); w.y = cvt_pk_bf16(v0[2], v0[3]); w.z = cvt_pk_bf16(v1[0], v1[1]); w.w = cvt_pk_bf16(v1[2], v1[3]);
                    const int cb = u.pn * BM + bj * HALF;
                    bf16_t* dst;
                    if (cb < 3072) dst = O + (size_t)row * ldc + cb + cw;
                    else { const int idx = (cb - 3072) >> 7, which = idx >> 3, head = idx & 7;
                        dst = QKVC + (size_t)which * ((size_t)16384 * 1024) + ((size_t)((row >> 12) * 8 + head) * 4096 + (row & 4095)) * 128 + cw; }
                    *(u32x4*)dst = w; } }
    }
};
struct EpiSwiGLU {
    static constexpr bool PERM = true, AFTER_DRAIN = false;
    bf16_t* O; int ldc; const float* rowss;
    __device__ __forceinline__ void operator()(const f32x4 (&acc)[2][2][4][2], const Unit& u, int wr, int wc, int fr, int fq) const {
        const int row0 = u.pm * BM + wr * 64 + fr; const int col0 = u.pn * HALF + wc * 32 + 8 * fq;
#pragma unroll
        for (int ai = 0; ai < 2; ++ai)
#pragma unroll
            for (int m = 0; m < 4; ++m) { bf16_t* rowp = O + (size_t)(row0 + ai * HALF + m * 16) * ldc + col0;
                const float rs = rowss ? 1.0f / sqrtf(rowss[row0 + ai * HALF + m * 16] * (1.0f / 2048.0f) + 1e-6f) : 1.0f;
                const f32x4 g0 = acc[ai][0][m][0] * rs, g1 = acc[ai][0][m][1] * rs, u0 = acc[ai][1][m][0] * rs, u1 = acc[ai][1][m][1] * rs;
                float h[8];
#pragma unroll
                for (int j = 0; j < 4; ++j) { h[j] = silu_f(g0[j]) * u0[j]; h[4 + j] = silu_f(g1[j]) * u1[j]; }
                u32x4 w; w.x = cvt_pk_bf16(h[0], h[1]); w.y = cvt_pk_bf16(h[2], h[3]); w.z = cvt_pk_bf16(h[4], h[5]); w.w = cvt_pk_bf16(h[6], h[7]);
                *(u32x4*)rowp = w; }
    }
};
template <bool BASE_BF16> struct EpiResidNorm {
    static constexpr bool PERM = false, AFTER_DRAIN = false;
    const void* base; bf16_t* xn; float* rowss; int ldc; float scale;
    __device__ __forceinline__ void operator()(const f32x4 (&acc)[2][2][4][2], const Unit& u, int wr, int wc, int fr, int fq) const {
        typedef unsigned u32x2 __attribute__((ext_vector_type(2)));
        const int col0 = u.pn * BM + wc * 32 + 4 * fq;
#pragma unroll
        for (int ai = 0; ai < 2; ++ai)
#pragma unroll
            for (int m = 0; m < 4; ++m) { const int row = u.pm * BM + ai * HALF + wr * 64 + m * 16 + fr; const size_t off = (size_t)row * ldc + col0;
                float ss = 0.f;
#pragma unroll
                for (int bj = 0; bj < 2; ++bj)
#pragma unroll
                    for (int n = 0; n < 2; ++n) { f32x4 bs;
                        if (BASE_BF16) { const u32x2 t = *(const u32x2*)((const bf16_t*)base + off + bj * HALF + n * 16);
                            bs = (f32x4){__builtin_bit_cast(float, t.x << 16), __builtin_bit_cast(float, t.x & 0xffff0000u), __builtin_bit_cast(float, t.y << 16), __builtin_bit_cast(float, t.y & 0xffff0000u)}; }
                        else bs = *(const f32x4*)((const float*)base + off + bj * HALF + n * 16);
                        const f32x4 v = bs + acc[ai][bj][m][n] * scale;
                        u32x2 w; w.x = cvt_pk_bf16(v[0], v[1]); w.y = cvt_pk_bf16(v[2], v[3]);
                        *(u32x2*)(xn + off + bj * HALF + n * 16) = w;
                        ss += (v[0] * v[0] + v[1] * v[1]) + (v[2] * v[2] + v[3] * v[3]); }
                ss += __shfl_xor(ss, 16); ss += __shfl_xor(ss, 32);
                if (fq == 0) __hip_atomic_fetch_add(rowss + row, ss, __ATOMIC_RELAXED, __HIP_MEMORY_SCOPE_AGENT); }
    }
};
struct EpiResid {
    static constexpr bool PERM = false, AFTER_DRAIN = false;
    const bf16_t* base; float* out; int ldc; float scale;
    __device__ __forceinline__ void operator()(const f32x4 (&acc)[2][2][4][2], const Unit& u, int wr, int wc, int fr, int fq) const {
        typedef unsigned u32x2 __attribute__((ext_vector_type(2)));
        const int col0 = u.pn * BM + wc * 32 + 4 * fq;
#pragma unroll
        for (int ai = 0; ai < 2; ++ai)
#pragma unroll
            for (int m = 0; m < 4; ++m) { const size_t off = (size_t)(u.pm * BM + ai * HALF + wr * 64 + m * 16 + fr) * ldc + col0;
#pragma unroll
                for (int bj = 0; bj < 2; ++bj)
#pragma unroll
                    for (int n = 0; n < 2; ++n) { const u32x2 t = *(const u32x2*)(base + off + bj * HALF + n * 16);
                        const f32x4 bs = (f32x4){__builtin_bit_cast(float, t.x << 16), __builtin_bit_cast(float, t.x & 0xffff0000u), __builtin_bit_cast(float, t.y << 16), __builtin_bit_cast(float, t.y & 0xffff0000u)};
                        *(f32x4*)(out + off + bj * HALF + n * 16) = bs + acc[ai][bj][m][n] * scale; } }
    }
};

template <class Epi, class Sched, bool ALIGN_EPI = false, bool SP2 = false>
__device__ __forceinline__ void gemm_phase(PG8_LAS unsigned char* lds, const Gemm g, const Sched& S, const Epi& E, int wave_in) {
    int tid_; { int l_; asm volatile("v_mbcnt_lo_u32_b32 %0, -1, 0\n\tv_mbcnt_hi_u32_b32 %0, -1, %0" : "=v"(l_)); tid_ = wave_in * 64 + l_; }
    const int tid = tid_, wid = __builtin_amdgcn_readfirstlane(tid >> 6), lane = tid & 63, wr = wid >> 2, wc = wid & 3, fr = lane & 15, fq = lane >> 4;
    const int K = g.K, nt = K / BK;
    unsigned voffA[2], voffB[2];
#pragma unroll
    for (int i = 0; i < 2; ++i) { int R, C; stage_rc(tid * 16 + i * 8192, R, C); const int Rb = Epi::PERM ? ((R & ~31) + perm32(R & 31)) : R;
        voffA[i] = (unsigned)(R * K + C) * 2u; voffB[i] = (unsigned)(Rb * K + C) * 2u; }
    const size_t kstep = (size_t)(BK * 2);
    const size_t hstep = (size_t)HALF * K * 2;
    const size_t tstep = 2 * hstep;
    const unsigned ldsw = (unsigned)wid * 1024u;
    const int aoff = lds_byte(wr * 64 + fr, fq * 8), boff = lds_byte(wc * 32 + fr, fq * 8);
#define PG8_SA(b, h) (((b) * 2 + (h)) * HTB)
#define PG8_SB(b, h) ((4 + (b) * 2 + (h)) * HTB)
#define PG8_STAGE(bufoff, gbase, voff) do { _Pragma("unroll") for (int _i = 0; _i < 2; ++_i) \
        __builtin_amdgcn_global_load_lds((const unsigned*)((const char*)(gbase) + (voff)[_i]), (PG8_LAS unsigned*)(lds + (bufoff) + ldsw + _i * 8192), 16, 0, 0); } while (0)
#define PG8_LDA(dst, b, h) do { _Pragma("unroll") for (int m = 0; m < 4; ++m) _Pragma("unroll") for (int k = 0; k < 2; ++k) dst[m][k] = *(const PG8_LAS bf16x8*)(lds + PG8_SA(b, h) + aoff + m * 2048 + k * 1024); } while (0)
#define PG8_LDB(dst, b, h) do { _Pragma("unroll") for (int n = 0; n < 2; ++n) _Pragma("unroll") for (int k = 0; k < 2; ++k) dst[n][k] = *(const PG8_LAS bf16x8*)(lds + PG8_SB(b, h) + boff + n * 2048 + k * 1024); } while (0)
#define PG8_MMA(ai, bj, At, Bt) do { __builtin_amdgcn_s_setprio(1); _Pragma("unroll") for (int m = 0; m < 4; ++m) _Pragma("unroll") for (int n = 0; n < 2; ++n) _Pragma("unroll") for (int k = 0; k < 2; ++k) \
        acc[ai][bj][m][n] = __builtin_amdgcn_mfma_f32_16x16x32_bf16(Bt[n][k], At[m][k], acc[ai][bj][m][n], 0, 0, 0); __builtin_amdgcn_s_setprio(0); } while (0)
#define PG8_WAIT_V(n) asm volatile("s_waitcnt vmcnt(" #n ")" ::: "memory")
#define PG8_WAIT_L(n) asm volatile("s_waitcnt lgkmcnt(" #n ")" ::: "memory")
#define PG8_BAR __builtin_amdgcn_s_barrier()
#define PG8_SCHED __builtin_amdgcn_sched_barrier(0)
    Unit cur, nxt; int ui = 0;
    if (!S.next(0, cur)) return;
    f32x4 acc[2][2][4][2];
#pragma unroll
    for (int a = 0; a < 2; ++a)
#pragma unroll
        for (int b = 0; b < 2; ++b)
#pragma unroll
            for (int m = 0; m < 4; ++m)
#pragma unroll
                for (int n = 0; n < 2; ++n) acc[a][b][m][n] = (f32x4){0.f, 0.f, 0.f, 0.f};
    bf16x8 At[4][2], B0[2][2], B1[2][2];
    const char* cA = (const char*)g.A + (size_t)cur.pm * tstep; const char* cB = (const char*)g.Bt + (size_t)cur.pn * tstep;
    S.a_ready(cur);
    if constexpr (SP2) {
        PG8_STAGE(PG8_SB(0, 0), cB, voffB); PG8_STAGE(PG8_SB(0, 1), cB + hstep, voffB); PG8_STAGE(PG8_SA(0, 0), cA, voffA); PG8_STAGE(PG8_SA(0, 1), cA + hstep, voffA);
        if (wr == 1) PG8_BAR;
        PG8_WAIT_V(2); PG8_BAR;
        PG8_STAGE(PG8_SB(1, 0), cB + kstep, voffB); PG8_STAGE(PG8_SA(1, 0), cA + kstep, voffA); PG8_STAGE(PG8_SB(1, 1), cB + hstep + kstep, voffB);
        PG8_WAIT_V(6); PG8_BAR;
    } else {
        PG8_STAGE(PG8_SB(0, 0), cB, voffB); PG8_STAGE(PG8_SA(0, 0), cA, voffA); PG8_STAGE(PG8_SB(0, 1), cB + hstep, voffB); PG8_STAGE(PG8_SA(0, 1), cA + hstep, voffA);
        if (wr == 1) PG8_BAR;
        PG8_WAIT_V(4); PG8_BAR;
        PG8_STAGE(PG8_SB(1, 0), cB + kstep, voffB); PG8_STAGE(PG8_SA(1, 0), cA + kstep, voffA); PG8_STAGE(PG8_SB(1, 1), cB + hstep + kstep, voffB);
        PG8_WAIT_V(6); PG8_BAR;
    }
    for (;;) {
        const bool has_next = S.next(ui + 1, nxt);
        const char* nA = has_next ? (const char*)g.A + (size_t)nxt.pm * tstep : cA; const char* nB = has_next ? (const char*)g.Bt + (size_t)nxt.pn * tstep : cB;
        for (int t = 0; t < nt; t += 2) {
            const bool last = (t == nt - 2);
            const char* a1 = cA + (size_t)(t + 1) * kstep;
            const char* a2 = last ? nA : cA + (size_t)(t + 2) * kstep; const char* b2 = last ? nB : cB + (size_t)(t + 2) * kstep;
            const char* a3 = a2 + kstep; const char* b3 = b2 + kstep;
            if (last && has_next) S.a_ready(nxt);
            if constexpr (SP2) {
            PG8_LDB(B0, 0, 0); PG8_LDB(B1, 0, 1); PG8_SCHED; PG8_LDA(At, 0, 0); PG8_STAGE(PG8_SA(1, 1), a1 + hstep, voffA);
            PG8_WAIT_V(8); PG8_WAIT_L(0); PG8_BAR; PG8_MMA(0, 0, At, B0); PG8_MMA(0, 1, At, B1); PG8_BAR; PG8_SCHED;
            PG8_LDA(At, 0, 1); PG8_STAGE(PG8_SB(0, 0), b2, voffB); PG8_STAGE(PG8_SB(0, 1), b2 + hstep, voffB); PG8_STAGE(PG8_SA(0, 0), a2, voffA);
            PG8_WAIT_V(8); PG8_WAIT_L(0); PG8_BAR; PG8_MMA(1, 0, At, B0); PG8_MMA(1, 1, At, B1); PG8_BAR; PG8_SCHED;
            PG8_LDB(B0, 1, 0); PG8_LDB(B1, 1, 1); PG8_SCHED; PG8_LDA(At, 1, 0); PG8_STAGE(PG8_SA(0, 1), a2 + hstep, voffA);
            PG8_WAIT_V(8); PG8_WAIT_L(0); PG8_BAR; PG8_MMA(0, 0, At, B0); PG8_MMA(0, 1, At, B1); PG8_BAR; PG8_SCHED;
            PG8_LDA(At, 1, 1); PG8_STAGE(PG8_SB(1, 0), b3, voffB); PG8_STAGE(PG8_SB(1, 1), b3 + hstep, voffB); PG8_STAGE(PG8_SA(1, 0), a3, voffA);
            PG8_WAIT_V(8); PG8_WAIT_L(0); PG8_BAR; PG8_MMA(1, 0, At, B0); PG8_MMA(1, 1, At, B1); PG8_BAR; PG8_SCHED;
            } else {
            PG8_LDB(B0, 0, 0); PG8_SCHED; PG8_LDA(At, 0, 0); PG8_STAGE(PG8_SA(1, 1), a1 + hstep, voffA);
            PG8_WAIT_L(8); PG8_BAR; PG8_WAIT_L(0); PG8_MMA(0, 0, At, B0); PG8_BAR; PG8_SCHED;
            PG8_LDB(B1, 0, 1); PG8_STAGE(PG8_SB(0, 0), b2, voffB);
            PG8_BAR; PG8_WAIT_L(0); PG8_MMA(0, 1, At, B1); PG8_BAR;
            PG8_LDA(At, 0, 1); PG8_STAGE(PG8_SA(0, 0), a2, voffA);
            PG8_BAR; PG8_WAIT_L(0); PG8_MMA(1, 0, At, B0); PG8_BAR; PG8_SCHED;
            PG8_STAGE(PG8_SB(0, 1), b2 + hstep, voffB);
            PG8_WAIT_V(6); PG8_BAR; PG8_MMA(1, 1, At, B1); PG8_BAR;
            PG8_LDB(B0, 1, 0); PG8_SCHED; PG8_LDA(At, 1, 0); PG8_STAGE(PG8_SA(0, 1), a2 + hstep, voffA);
            PG8_WAIT_L(8); PG8_BAR; PG8_WAIT_L(0); PG8_MMA(0, 0, At, B0); PG8_BAR; PG8_SCHED;
            PG8_LDB(B1, 1, 1); PG8_STAGE(PG8_SB(1, 0), b3, voffB);
            PG8_BAR; PG8_WAIT_L(0); PG8_MMA(0, 1, At, B1); PG8_BAR;
            PG8_LDA(At, 1, 1); PG8_STAGE(PG8_SA(1, 0), a3, voffA);
            PG8_BAR; PG8_WAIT_L(0); PG8_MMA(1, 0, At, B0); PG8_BAR; PG8_SCHED;
            PG8_STAGE(PG8_SB(1, 1), b3 + hstep, voffB);
            PG8_WAIT_V(6); PG8_BAR; PG8_MMA(1, 1, At, B1); PG8_BAR;
            }
        }
        if constexpr (ALIGN_EPI) { if (wr == 0) PG8_BAR; }
        if constexpr (!Epi::AFTER_DRAIN) { E(acc, cur, wr, wc, fr, fq); S.done(cur); }
        if (!has_next) break;
#pragma unroll
        for (int a = 0; a < 2; ++a)
#pragma unroll
            for (int b = 0; b < 2; ++b)
#pragma unroll
                for (int m = 0; m < 4; ++m)
#pragma unroll
                    for (int n = 0; n < 2; ++n) acc[a][b][m][n] = (f32x4){0.f, 0.f, 0.f, 0.f};
        cur = nxt; cA = nA; cB = nB; ++ui;
        if constexpr (ALIGN_EPI) { if (wr == 1) PG8_BAR; }
    }
    PG8_WAIT_V(0);
    if constexpr (!ALIGN_EPI) { if (wr == 0) PG8_BAR; }
    PG8_BAR;
    if constexpr (Epi::AFTER_DRAIN) { E.fused(acc, cur, wr, wc, fr, fq, lds, wid, lane); S.done(cur); }
#undef PG8_SA
#undef PG8_SB
#undef PG8_STAGE
#undef PG8_LDA
#undef PG8_LDB
#undef PG8_MMA
#undef PG8_WAIT_V
#undef PG8_WAIT_L
#undef PG8_BAR
#undef PG8_SCHED
}
}
#define LAS __attribute__((address_space(3)))
typedef unsigned short bf16_t;
typedef short bf16x8 __attribute__((ext_vector_type(8)));
typedef short s16x4 __attribute__((ext_vector_type(4)));
typedef float f32x4 __attribute__((ext_vector_type(4)));
typedef float f32x2 __attribute__((ext_vector_type(2)));
typedef unsigned u32x4 __attribute__((ext_vector_type(4)));
typedef unsigned u32x2 __attribute__((ext_vector_type(2)));
typedef __bf16 bf16x2_t __attribute__((ext_vector_type(2)));

constexpr int NB = 4, SEQ = 4096, DM = 2048, FF = 5632, MTOK = NB * SEQ;
constexpr int ZP = 3072, DIN_SRC = 6160;
constexpr int C_QG = 0, C_KG = 512, C_VG = 1024, C_RG = 2048;
constexpr size_t QKV_ELEMS = (size_t)MTOK * 1024;
constexpr float EPS = 1e-6f;
constexpr size_t MiB = 1u << 20;
constexpr size_t WS_WGU1 = 0, WS_WD1 = 44 * MiB, WS_WIN = 66 * MiB, WS_WOUT = 91 * MiB, WS_WGU2 = 99 * MiB, WS_WD2 = 143 * MiB;
constexpr size_t WS_XN = 165 * MiB, WS_HZ = 229 * MiB, WS_ROPE = 429 * MiB, WS_EV = 431 * MiB, WS_GS = 433 * MiB, WS_RS = 497 * MiB, WS_BAR = 498 * MiB, WS_END = 499 * MiB;
constexpr size_t WS_QKVC = 229 * MiB + 96 * MiB;
constexpr size_t WS_OBR = 0, WS_LSE = 64 * MiB, WS_XN2 = 0;
constexpr int LDS_BYTES = 147456;

struct Params {
    const float* x; const float* n1; const float* wg1; const float* wu1; const float* wd1; const float* nmix; const float* win;
    const float* gup; const float* gbias; const float* gonorm; const float* qn; const float* kn; const float* wout;
    const float* n2; const float* wg2; const float* wu2; const float* wd2;
    float* out; unsigned char* ws;
};

__device__ __forceinline__ unsigned cvtpk(float lo, float hi) { f32x2 v = {lo, hi}; bf16x2_t b = __builtin_convertvector(v, bf16x2_t); return __builtin_bit_cast(unsigned, b); }
__device__ __forceinline__ float bf2f(unsigned short h) { return __builtin_bit_cast(float, (unsigned)h << 16); }
__device__ __forceinline__ float bflo(unsigned w) { return __builtin_bit_cast(float, w << 16); }
__device__ __forceinline__ float bfhi(unsigned w) { return __builtin_bit_cast(float, w & 0xffff0000u); }
__device__ __forceinline__ int hw_lane() { int l; asm volatile("v_mbcnt_lo_u32_b32 %0, -1, 0\n\tv_mbcnt_hi_u32_b32 %0, -1, %0" : "=v"(l)); return l; }
__device__ __forceinline__ int ltid(int wave) { return wave * 64 + hw_lane(); }
__device__ __forceinline__ float fexp(float x) { return __builtin_amdgcn_exp2f(x * 1.44269504089f); }
__device__ __forceinline__ float wave_sum(float v) {
#pragma unroll
    for (int o = 1; o < 64; o <<= 1) v += __shfl_xor(v, o);
    return v;
}
__device__ __forceinline__ f32x4 mfma16(bf16x8 a, bf16x8 b, f32x4 c) { return __builtin_amdgcn_mfma_f32_16x16x32_bf16(a, b, c, 0, 0, 0); }
__device__ __forceinline__ s16x4 vtr(const LAS unsigned char* p) { return __builtin_bit_cast(s16x4, __builtin_amdgcn_ds_read_tr16_b64_v4i16((LAS s16x4*)p)); }
__device__ __forceinline__ bf16x8 cat8(s16x4 a, s16x4 b) { bf16x8 r; r[0] = a[0]; r[1] = a[1]; r[2] = a[2]; r[3] = a[3]; r[4] = b[0]; r[5] = b[1]; r[6] = b[2]; r[7] = b[3]; return r; }
__device__ __forceinline__ bf16x8 pack8(f32x4 a, f32x4 b) { u32x4 w; w.x = cvtpk(a[0], a[1]); w.y = cvtpk(a[2], a[3]); w.z = cvtpk(b[0], b[1]); w.w = cvtpk(b[2], b[3]); return __builtin_bit_cast(bf16x8, w); }

#define XB_TMO      128
#define XB_XCNT(j)  (256  + 64 * (j))
#define XB_XSUB(j)  (1280 + 64 * (j))
#define XB_XGEN(j)  (2304 + 64 * (j))
#define XB_TOP      3328
#define XB_TOPGEN   3392
#define XCD_BAR_WORDS 3456
#define XB_SPIN_CAP (1u << 18)

__device__ __forceinline__ unsigned xb_ld(unsigned* p)              { return __hip_atomic_load(p, __ATOMIC_RELAXED, __HIP_MEMORY_SCOPE_AGENT); }
__device__ __forceinline__ unsigned xb_add(unsigned* p, unsigned v) { return __hip_atomic_fetch_add(p, v, __ATOMIC_RELAXED, __HIP_MEMORY_SCOPE_AGENT); }
__device__ __forceinline__ unsigned xb_xcc_id() { return (unsigned)__builtin_amdgcn_s_getreg((3 << 11) | 20) & 0xFu; }
#define XB_SPIN(cond, bar) do { unsigned _sp = 0; while (cond) { __builtin_amdgcn_s_sleep(1); \
    if ((++_sp & 255u) == 0u) { if (xb_ld(&(bar)[XB_TMO])) break; if (_sp > XB_SPIN_CAP) { atomicAdd(&(bar)[XB_TMO], 1u); break; } } } } while (0)

struct XcdBarrier {
    unsigned* bar; unsigned x;
    volatile LAS unsigned* st;
};

__device__ __forceinline__ XcdBarrier xcd_barrier_post(unsigned* bar, volatile LAS unsigned* st, bool leader) {
    XcdBarrier b; b.bar = bar; b.x = xb_xcc_id(); b.st = st;
    if (leader) (void)xb_add(&bar[XB_XCNT(b.x)], 1u);
    return b;
}
__device__ __forceinline__ void xcd_barrier_complete(unsigned* bar, unsigned x, unsigned& nloc, unsigned& nx) {
    const unsigned G = gridDim.x * gridDim.y * gridDim.z;
    unsigned sum, cnt, mine, sp = 0u;
    for (;;) {
        sum = 0u; cnt = 0u; mine = 0u;
#pragma unroll
        for (unsigned j = 0; j < 16; ++j) { const unsigned c = xb_ld(&bar[XB_XCNT(j)]); sum += c; cnt += (c > 0u) ? 1u : 0u; mine = (j == x) ? c : mine; }
        if (sum == G) break;
        __builtin_amdgcn_s_sleep(1);
        if ((++sp & 255u) == 0u) { if (xb_ld(&bar[XB_TMO])) break; if (sp > XB_SPIN_CAP) { atomicAdd(&bar[XB_TMO], 1u); break; } }
    }
    nloc = mine > 0u ? mine : 1u; nx = cnt > 0u ? cnt : 1u;
}

__device__ __forceinline__ void xcd_barrier(const XcdBarrier& b, bool leader) {
    asm volatile("s_waitcnt vmcnt(0)" ::: "memory");
    __syncthreads();
    if (leader) {
        unsigned* bar = b.bar;
        __builtin_amdgcn_s_waitcnt(0);
        unsigned nloc = b.st[0], nx = b.st[1];
        if (nloc == 0u) { xcd_barrier_complete(bar, b.x, nloc, nx); b.st[0] = nloc; b.st[1] = nx; }
        const unsigned old = xb_add(&bar[XB_XSUB(b.x)], 1u);
        const unsigned gen = old / nloc;
        if (old + 1u == (gen + 1u) * nloc) {
            __builtin_amdgcn_fence(__ATOMIC_RELEASE, "agent");
            asm volatile("s_waitcnt vmcnt(0)" ::: "memory");
            const unsigned og = xb_add(&bar[XB_TOP], 1u);
            const unsigned tg = og / nx;
            if (og + 1u == (tg + 1u) * nx) xb_add(&bar[XB_TOPGEN], 1u);
            else XB_SPIN(xb_ld(&bar[XB_TOPGEN]) == tg, bar);
            __builtin_amdgcn_fence(__ATOMIC_ACQUIRE, "agent");
            xb_add(&bar[XB_XGEN(b.x)], 1u);
            asm volatile("s_waitcnt vmcnt(0)" ::: "memory");
        } else {
            XB_SPIN(xb_ld(&bar[XB_XGEN(b.x)]) == gen, bar);
            __builtin_amdgcn_fence(__ATOMIC_ACQUIRE, "agent");
            asm volatile("s_waitcnt vmcnt(0)" ::: "memory");
        }
    }
    __syncthreads();
}

struct TrArgs { const float* W; const float* gk; bf16_t* WT; int ldsrc, k0, srccol0, nvalid, K, dstrow0; };
__device__ __forceinline__ void tr_load(const TrArgs& a, float (&vv)[32], int lane) {
    const int c = lane & 31;
    if (c < a.nvalid) {
        const float* src = a.W + (size_t)(a.k0 + (lane >> 5)) * a.ldsrc + a.srccol0 + c;
#pragma unroll
        for (int i = 0; i < 32; ++i) vv[i] = __builtin_nontemporal_load(src + (size_t)(2 * i) * a.ldsrc);
    } else {
#pragma unroll
        for (int i = 0; i < 32; ++i) vv[i] = 0.f;
    }
}
__device__ __forceinline__ void tr_store(const TrArgs& a, const float (&vv)[32], LAS float* scr, int lane) {
    const int c = lane & 31, c8 = lane & 7;
    f32x4 g0 = (f32x4){1.f, 1.f, 1.f, 1.f}, g1 = g0;
    if (a.gk) { g0 = *(const f32x4*)(a.gk + a.k0 + 8 * c8); g1 = *(const f32x4*)(a.gk + a.k0 + 8 * c8 + 4); }
#pragma unroll
    for (int i = 0; i < 32; ++i) scr[(2 * i + (lane >> 5)) * 33 + c] = vv[i];
    asm volatile("s_waitcnt lgkmcnt(0)" ::: "memory");
#pragma unroll
    for (int j = 0; j < 4; ++j) { const int n = (lane >> 3) + 8 * j; const LAS float* s = scr + (8 * c8) * 33 + n;
        u32x4 o; o.x = cvtpk(s[0 * 33] * g0[0], s[1 * 33] * g0[1]); o.y = cvtpk(s[2 * 33] * g0[2], s[3 * 33] * g0[3]);
        o.z = cvtpk(s[4 * 33] * g1[0], s[5 * 33] * g1[1]); o.w = cvtpk(s[6 * 33] * g1[2], s[7 * 33] * g1[3]);
        *(u32x4*)(a.WT + (size_t)(a.dstrow0 + n) * a.K + a.k0 + 8 * c8) = o; }
    asm volatile("s_waitcnt lgkmcnt(0)" ::: "memory");
}
constexpr int TR_I_GU = 32 * 352, TR_I_D = 88 * 64, TR_I_IN = 32 * 200, TR_I_OUT = 32 * 64, TR_NITEMS = 2 * TR_I_GU + 2 * TR_I_D + TR_I_IN + TR_I_OUT;
__device__ __forceinline__ TrArgs tr_decode(const Params& p, int it) {
    TrArgs a; int r = it;
    if (r < 2 * TR_I_GU) { const bool second = r >= TR_I_GU; if (second) r -= TR_I_GU;
        const int kb = r / 352, nb = r % 352, pn = nb >> 3, sub = nb & 7;
        a.W = sub < 4 ? (second ? p.wg2 : p.wg1) : (second ? p.wu2 : p.wu1); a.gk = second ? p.n2 : p.n1; a.WT = (bf16_t*)(p.ws + (second ? WS_WGU2 : WS_WGU1));
        a.ldsrc = FF; a.k0 = 64 * kb; a.srccol0 = 128 * pn + 32 * (sub & 3); a.nvalid = 32; a.K = DM; a.dstrow0 = 32 * nb; return a; }
    r -= 2 * TR_I_GU;
    if (r < 2 * TR_I_D) { const bool second = r >= TR_I_D; if (second) r -= TR_I_D;
        a.W = second ? p.wd2 : p.wd1; a.gk = nullptr; a.WT = (bf16_t*)(p.ws + (second ? WS_WD2 : WS_WD1));
        a.ldsrc = DM; a.k0 = 64 * (r / 64); a.srccol0 = 32 * (r % 64); a.nvalid = 32; a.K = FF; a.dstrow0 = 32 * (r % 64); return a; }
    r -= 2 * TR_I_D;
    if (r < TR_I_IN) { const int kb = r / 200, nb = r % 200, n0 = 32 * nb; int src, nv;
        if (n0 < 2048) { src = n0; nv = 32; } else if (n0 < 6144) { src = n0 + 16; nv = 32; } else if (n0 == 6144) { src = 2048; nv = 16; } else { src = 0; nv = 0; }
        a.W = p.win; a.gk = p.nmix; a.WT = (bf16_t*)(p.ws + WS_WIN); a.ldsrc = DIN_SRC; a.k0 = 64 * kb; a.srccol0 = src; a.nvalid = nv; a.K = DM; a.dstrow0 = n0; return a; }
    r -= TR_I_IN;
    a.W = p.wout; a.gk = nullptr; a.WT = (bf16_t*)(p.ws + WS_WOUT); a.ldsrc = DM; a.k0 = 64 * (r / 64); a.srccol0 = 32 * (r % 64); a.nvalid = 32; a.K = DM; a.dstrow0 = 32 * (r % 64); return a;
}
__device__ __forceinline__ void convert_items(const Params& p, LAS float* scr, int lane, int it0, int it_end, int stride) {
    int it = it0; TrArgs a{}; float vv[32];
    if (it < it_end) { a = tr_decode(p, it); tr_load(a, vv, lane); }
    while (it < it_end) {
        const int nx = it + stride; TrArgs bnx = a; float vn[32];
        if (nx < it_end) { bnx = tr_decode(p, nx); tr_load(bnx, vn, lane); }
        else {
#pragma unroll
            for (int i = 0; i < 32; ++i) vn[i] = 0.f; }
        tr_store(a, vv, scr, lane);
        a = bnx;
#pragma unroll
        for (int i = 0; i < 32; ++i) vv[i] = vn[i];
        it = nx; }
}
__device__ __forceinline__ void rms_row_to_bf16(const float* xrow, bf16_t* orow, int lane) {
    const f32x4* xr = (const f32x4*)xrow + lane;
    f32x4 v[8]; float s = 0.f;
#pragma unroll
    for (int j = 0; j < 8; ++j) { v[j] = xr[64 * j]; s += (v[j].x * v[j].x + v[j].y * v[j].y) + (v[j].z * v[j].z + v[j].w * v[j].w); }
    const float rstd = 1.0f / sqrtf(wave_sum(s) * (1.0f / DM) + EPS);
    u32x2* o8 = (u32x2*)orow + lane;
#pragma unroll
    for (int j = 0; j < 8; ++j) { u32x2 w; w.x = cvtpk(v[j].x * rstd, v[j].y * rstd); w.y = cvtpk(v[j].z * rstd, v[j].w * rstd); o8[64 * j] = w; }
}
__device__ __forceinline__ void norm_pass(const float* src, bf16_t* XN, int gw, int NGW, int lane) {
    lane = hw_lane();
    for (int m = gw; m < MTOK; m += NGW) rms_row_to_bf16(src + (size_t)m * DM, XN + (size_t)m * DM, lane);
}
__device__ __forceinline__ void phase_prologue(const Params& p, LAS unsigned char* lds, int wave, int lane) {
    lane = hw_lane();
    LAS float* scr = (LAS float*)(lds + wave * 16384);
    const int gw = blockIdx.x * 8 + wave, NGW = gridDim.x * 8;
    convert_items(p, scr, lane, gw, (gridDim.x == 256) ? TR_I_GU : TR_NITEMS, NGW);
    f32x2* cs = (f32x2*)(p.ws + WS_ROPE);
    for (int idx = blockIdx.x * 512 + wave * 64 + lane; idx < SEQ * 64; idx += gridDim.x * 512) {
        const int pos = idx >> 6, i = idx & 63;
        double inv = 1.0; for (int k = 0; k < i; ++k) inv *= 0.8659643233600653;
        double a = (double)pos * inv;
        const double kq = __builtin_rint(a * 0.6366197723675814);
        double t = a - kq * 1.5707963267948966; t -= kq * 6.123233995736766e-17;
        const double t2 = t * t;
        double sn = t * (1.0 + t2 * (-1.0 / 6 + t2 * (1.0 / 120 + t2 * (-1.0 / 5040 + t2 * (1.0 / 362880 + t2 * (-1.0 / 39916800 + t2 * (1.0 / 6227020800.0)))))));
        double cn = 1.0 + t2 * (-0.5 + t2 * (1.0 / 24 + t2 * (-1.0 / 720 + t2 * (1.0 / 40320 + t2 * (-1.0 / 3628800 + t2 * (1.0 / 479001600.0 + t2 * (-1.0 / 87178291200.0)))))));
        const int q = ((int)kq) & 3;
        double c = (q == 0) ? cn : (q == 1) ? -sn : (q == 2) ? -cn : sn;
        double s = (q == 0) ? sn : (q == 1) ? cn : (q == 2) ? -sn : -cn;
        cs[idx] = (f32x2){(float)c, (float)s};
    }
    { float* rs = (float*)(p.ws + WS_RS); for (int idx = blockIdx.x * 512 + wave * 64 + lane; idx < 2 * MTOK; idx += gridDim.x * 512) rs[idx] = 0.f; }
    norm_pass(p.x, (bf16_t*)(p.ws + WS_XN), gw, NGW, lane);
}

__device__ __forceinline__ void phase_qkrope_gla_prep(const Params& p, LAS unsigned char* lds, int wave, int lane) {
    bf16_t* Z = (bf16_t*)(p.ws + WS_HZ);
    const int tid = ltid(wave); lane = tid & 63;
    {
        LAS float* part = (LAS float*)lds;
        LAS float* gl = (LAS float*)(lds + 32768);
        float* E1 = (float*)(p.ws + WS_EV); float* E2 = E1 + 256 * 512; float* E3 = E2 + 256 * 512;
        const bf16_t* X1B = (const bf16_t*)p.out; const bf16_t* wgl = (const bf16_t*)(p.ws + WS_WIN) + (size_t)6144 * DM;
        const float* rss1 = (const float*)(p.ws + WS_RS);
        const int fr = lane & 15, g = lane >> 4, d = tid;
        for (int bc = blockIdx.x; bc < 256; bc += gridDim.x) {
            const int m0 = bc * 64;
            __syncthreads();
            f32x4 accg[4];
#pragma unroll
            for (int ti = 0; ti < 4; ++ti) accg[ti] = (f32x4){0.f, 0.f, 0.f, 0.f};
#pragma unroll
            for (int k8 = 0; k8 < 8; ++k8) { const int kk = 256 * wave + 32 * k8 + 8 * g;
                const bf16x8 bfr = *(const bf16x8*)(wgl + (size_t)fr * DM + kk);
#pragma unroll
                for (int ti = 0; ti < 4; ++ti) { const bf16x8 afr = *(const bf16x8*)(X1B + (size_t)(m0 + 16 * ti + fr) * DM + kk);
                    accg[ti] = mfma16(afr, bfr, accg[ti]); } }
#pragma unroll
            for (int ti = 0; ti < 4; ++ti)
#pragma unroll
                for (int jj = 0; jj < 4; ++jj) part[(wave * 64 + 16 * ti + 4 * g + jj) * 16 + fr] = accg[ti][jj];
            __syncthreads();
#pragma unroll
            for (int i = 0; i < 2; ++i) { const int idx = tid + 512 * i, tok = idx >> 4; float sum = 0.f;
#pragma unroll
                for (int w = 0; w < 8; ++w) sum += part[w * 1024 + idx];
                gl[idx] = sum / sqrtf(rss1[m0 + tok] * (1.0f / DM) + EPS); }
            float gu[16];
#pragma unroll
            for (int r = 0; r < 16; ++r) gu[r] = p.gup[r * 512 + d];
            const float bias = p.gbias[d];
            __syncthreads();
            float bl[64]; float run = 0.f;
#pragma unroll
            for (int t = 0; t < 64; ++t) { float lg = bias;
#pragma unroll
                for (int r = 0; r < 16; ++r) lg += gl[t * 16 + r] * gu[r];
                const float ls = fminf(lg, 0.f) - 0.69314718056f * __builtin_amdgcn_logf(1.0f + fexp(-fabsf(lg)));
                run += ls * (1.0f / 16.0f); bl[t] = run; }
            const float bref = bl[31], blast = bl[63];
#pragma unroll
            for (int tb = 0; tb < 4; ++tb) {
                unsigned short qv[16], kv[16];
#pragma unroll
                for (int t = 0; t < 16; ++t) { const size_t ro = (size_t)(m0 + 16 * tb + t) * ZP + d; qv[t] = Z[ro + C_QG]; kv[t] = Z[ro + C_KG]; }
#pragma unroll
                for (int t = 0; t < 16; ++t) { const size_t ro = (size_t)(m0 + 16 * tb + t) * ZP + d; const float bb = bl[16 * tb + t];
                    const float qs = bf2f(qv[t]) * 0.08838834764831845f * fexp(bb - bref), ks = bf2f(kv[t]) * fexp(bref - bb);
                    Z[ro + C_QG] = (bf16_t)(cvtpk(qs, 0.f) & 0xffffu); Z[ro + C_KG] = (bf16_t)(cvtpk(ks, 0.f) & 0xffffu); }
            }
            { const size_t eo = (size_t)bc * 512 + d; E1[eo] = fexp(bref); E2[eo] = fexp(blast - bref); E3[eo] = fexp(blast); }
        }
        __syncthreads();
    }
    {
        const f32x2* cs = (const f32x2*)(p.ws + WS_ROPE);
        const int gw = blockIdx.x * 8 + wave, NGW = gridDim.x * 8;
        const int isk = lane >> 5, i = lane & 31;
        const float* gn = isk ? p.kn : p.qn;
        const float g1a = gn[2 * i], g1b = gn[2 * i + 1], g2a = gn[64 + 2 * i], g2b = gn[64 + 2 * i + 1];
        const float osc = isk ? 1.0f : 0.12751743082459868f;
        for (int m = gw; m < MTOK; m += NGW) {
            const int pos = m & (SEQ - 1);
            bf16_t* row0 = (bf16_t*)(p.ws + WS_QKVC) + (isk ? QKV_ELEMS : 0) + ((size_t)(m >> 12) * 8 * SEQ + pos) * 128;
            unsigned w1[8], w2[8];
#pragma unroll
            for (int h = 0; h < 8; ++h) { w1[h] = *(const unsigned*)(row0 + (size_t)h * SEQ * 128 + 2 * i); w2[h] = *(const unsigned*)(row0 + (size_t)h * SEQ * 128 + 64 + 2 * i); }
            const f32x4 c4 = *(const f32x4*)(cs + pos * 64 + 2 * i);
            unsigned o1[8], o2[8];
#pragma unroll
            for (int h = 0; h < 8; ++h) {
                const float x1a = bflo(w1[h]), x1b = bfhi(w1[h]), x2a = bflo(w2[h]), x2b = bfhi(w2[h]);
                float ss = (x1a * x1a + x1b * x1b) + (x2a * x2a + x2b * x2b);
#pragma unroll
                for (int o = 1; o < 32; o <<= 1) ss += __shfl_xor(ss, o);
                const float rstd = osc / sqrtf(ss * (1.0f / 128.0f) + EPS);
                const float y1a = x1a * rstd * g1a, y1b = x1b * rstd * g1b, y2a = x2a * rstd * g2a, y2b = x2b * rstd * g2b;
                const float o1a = y1a * c4.x - y2a * c4.y, o2a = y2a * c4.x + y1a * c4.y;
                const float o1b = y1b * c4.z - y2b * c4.w, o2b = y2b * c4.z + y1b * c4.w;
                o1[h] = cvtpk(o1a, o1b); o2[h] = cvtpk(o2a, o2b); }
#pragma unroll
            for (int h = 0; h < 8; ++h) { *(unsigned*)(row0 + (size_t)h * SEQ * 128 + 2 * i) = o1[h]; *(unsigned*)(row0 + (size_t)h * SEQ * 128 + 64 + 2 * i) = o2[h]; }
        }
    }
}

constexpr int G_QL = 0, G_KL = 17408, G_VL = 34816, G_PL = 68608, G_EL = 77824, G_SS = 79360, G_OL = 81408;
template <bool WITH_Q>
__device__ __forceinline__ void gla_stage(const bf16_t* Z, LAS unsigned char* lds, size_t m0, int h, int tid) {
    u32x4 pq[2], pk[2], pv[4];
#pragma unroll
    for (int i = 0; i < 2; ++i) { const int ci = tid + 512 * i, row = ci >> 4, cc = ci & 15;
        if (WITH_Q) pq[i] = *(const u32x4*)(Z + (m0 + row) * ZP + C_QG + h * 128 + 8 * cc);
        pk[i] = *(const u32x4*)(Z + (m0 + row) * ZP + C_KG + h * 128 + 8 * cc); }
#pragma unroll
    for (int i = 0; i < 4; ++i) { const int ci = tid + 512 * i, row = ci >> 5, cc = ci & 31;
        pv[i] = *(const u32x4*)(Z + (m0 + row) * ZP + C_VG + h * 256 + 8 * cc); }
#pragma unroll
    for (int i = 0; i < 2; ++i) { const int ci = tid + 512 * i, row = ci >> 4, cc = ci & 15;
        if (WITH_Q) *(LAS u32x4*)(lds + G_QL + row * 272 + cc * 16) = pq[i];
        *(LAS u32x4*)(lds + G_KL + row * 272 + cc * 16) = pk[i]; }
#pragma unroll
    for (int i = 0; i < 4; ++i) { const int ci = tid + 512 * i, row = ci >> 5, cc = ci & 31;
        *(LAS u32x4*)(lds + G_VL + row * 528 + cc * 16) = pv[i]; }
}
__device__ __forceinline__ void gla_passA(const Params& p, LAS unsigned char* lds, int item, int wave, int lane) {
    const bf16_t* Z = (const bf16_t*)(p.ws + WS_HZ);
    const float* EV = (const float*)(p.ws + WS_EV);
    bf16_t* GS = (bf16_t*)(p.ws + WS_GS);
    const int tid = ltid(wave); lane = tid & 63;
    const int c = item & 63, bh = item >> 6, b = bh >> 2, h = bh & 3, fr = lane & 15, g = lane >> 4;
    const size_t m0 = (size_t)b * SEQ + 64 * c;
    __syncthreads();
    gla_stage<false>(Z, lds, m0, h, tid);
    if (tid < 32) *(LAS f32x4*)(lds + G_EL + 512 + tid * 16) = *(const f32x4*)(EV + (size_t)256 * 512 + (size_t)(b * 64 + c) * 512 + h * 128 + 4 * tid);
    __syncthreads();
    bf16x8 vB[2][2];
#pragma unroll
    for (int ks = 0; ks < 2; ++ks)
#pragma unroll
        for (int dvi = 0; dvi < 2; ++dvi) { const LAS unsigned char* ap = lds + G_VL + (32 * ks + 8 * g + (fr >> 2)) * 528 + (32 * wave + 16 * dvi + 4 * (fr & 3)) * 2;
            vB[ks][dvi] = cat8(vtr(ap), vtr(ap + 4 * 528)); }
#pragma unroll
    for (int k4 = 0; k4 < 4; ++k4) {
        f32x4 u[2][2];
#pragma unroll
        for (int t = 0; t < 2; ++t) { const int dkt = 2 * k4 + t;
            f32x4 u0 = (f32x4){0.f, 0.f, 0.f, 0.f}, u1 = (f32x4){0.f, 0.f, 0.f, 0.f};
#pragma unroll
            for (int ks = 0; ks < 2; ++ks) { const LAS unsigned char* ap = lds + G_KL + (32 * ks + 8 * g + (fr >> 2)) * 272 + (16 * dkt + 4 * (fr & 3)) * 2;
                const bf16x8 a = cat8(vtr(ap), vtr(ap + 4 * 272));
                u0 = mfma16(a, vB[ks][0], u0); u1 = mfma16(a, vB[ks][1], u1); }
            const f32x4 e2 = *(const LAS f32x4*)(lds + G_EL + 512 + (16 * dkt + 4 * g) * 4);
            u[t][0] = u0 * e2; u[t][1] = u1 * e2; }
        bf16_t* dst = GS + (((size_t)item * 8 + wave) * 8 + k4 * 2) * 512 + lane * 8;
        *(bf16x8*)dst = pack8(u[0][0], u[1][0]);
        *(bf16x8*)(dst + 512) = pack8(u[0][1], u[1][1]);
    }
}
__device__ __forceinline__ void gla_scan(const Params& p, LAS unsigned char* lds, int wave) {
    const float* EV = (const float*)(p.ws + WS_EV);
    const int tid = ltid(wave);
    for (int T0 = blockIdx.x * 512; T0 < 16 * 8192; T0 += gridDim.x * 512) {
        const int bh = T0 >> 13, b = bh >> 2, h = bh & 3;
        __syncthreads();
#pragma unroll
        for (int i = 0; i < 4; ++i) { const int idx = tid + 512 * i, c = idx >> 5, j = idx & 31;
            const float* src = EV + (size_t)(b * 64 + c) * 512 + h * 128 + 4 * j;
            *(LAS f32x4*)(lds + (c * 128 + 4 * j) * 4) = *(const f32x4*)src;
            *(LAS f32x4*)(lds + 32768 + (c * 128 + 4 * j) * 4) = *(const f32x4*)(src + (size_t)2 * 256 * 512); }
        __syncthreads();
        const int T = T0 + tid, piece = T & 8191, ks = (piece >> 8) & 3, ln = (piece >> 1) & 63, half = piece & 1, g = ln >> 4;
        const int dk = 32 * ks + 16 * half + 4 * g;
        u32x2* base = (u32x2*)(p.ws + WS_GS) + (size_t)(bh * 64) * 8192 + piece;
        f32x4 s = (f32x4){0.f, 0.f, 0.f, 0.f};
        u32x2 ucur = base[0]; base[0] = (u32x2){0u, 0u};
#pragma unroll 1
        for (int cb = 0; cb < 4; ++cb) {
            u32x2 uu[16];
#pragma unroll
            for (int i = 0; i < 16; ++i) { const int cn = 16 * cb + i + 1; const int cl = cn < 64 ? cn : 63; uu[i] = base[(size_t)cl * 8192]; }
#pragma unroll
            for (int i = 0; i < 16; ++i) { const int cn = 16 * cb + i + 1;
                if (cn < 64) {
                    const f32x4 e3 = *(const LAS f32x4*)(lds + 32768 + ((cn - 1) * 128 + dk) * 4), e1 = *(const LAS f32x4*)(lds + (cn * 128 + dk) * 4);
                    const f32x4 uf = (f32x4){bflo(ucur.x), bfhi(ucur.x), bflo(ucur.y), bfhi(ucur.y)};
                    s = e3 * s + uf;
                    const f32x4 o = e1 * s; u32x2 w; w.x = cvtpk(o[0], o[1]); w.y = cvtpk(o[2], o[3]);
                    base[(size_t)cn * 8192] = w; ucur = uu[i]; } }
        }
    }
    __syncthreads();
}
__device__ __forceinline__ void gla_passC(const Params& p, LAS unsigned char* lds, int item, int wave, int lane) {
    const bf16_t* Z = (const bf16_t*)(p.ws + WS_HZ);
    bf16_t* OA = (bf16_t*)(p.ws + WS_XN);
    const bf16_t* GS = (const bf16_t*)(p.ws + WS_GS);
    const int tid = ltid(wave); lane = tid & 63;
    const int c = item & 63, bh = item >> 6, b = bh >> 2, h = bh & 3, fr = lane & 15, g = lane >> 4;
    const size_t m0 = (size_t)b * SEQ + 64 * c;
    const float gn0 = p.gonorm[32 * wave + fr], gn1 = p.gonorm[32 * wave + 16 + fr];
    LAS unsigned char* L = lds;
    __syncthreads();
    gla_stage<true>(Z, lds, m0, h, tid);
    __syncthreads();
    bf16x8 sbf[4][2];
#pragma unroll
    for (int ks = 0; ks < 4; ++ks) { const bf16_t* src = GS + (((size_t)item * 8 + wave) * 8 + ks * 2) * 512 + lane * 8;
        sbf[ks][0] = *(const bf16x8*)src; sbf[ks][1] = *(const bf16x8*)(src + 512); }
    u32x4 prg[4];
#pragma unroll
    for (int i = 0; i < 4; ++i) { const int ci = tid + 512 * i, row = ci >> 5, cc = ci & 31;
        prg[i] = *(const u32x4*)(Z + (m0 + row) * ZP + C_RG + h * 256 + 8 * cc); }
        {
            const int ti = wave >> 1;
#pragma unroll
            for (int jx = 0; jx < 2; ++jx) { const int tj = 2 * (wave & 1) + jx;
                f32x4 acc = (f32x4){0.f, 0.f, 0.f, 0.f};
                if (tj <= ti) {
#pragma unroll
                    for (int ks = 0; ks < 4; ++ks) {
                        const bf16x8 a = *(const LAS bf16x8*)(L + G_QL + (16 * ti + fr) * 272 + (32 * ks + 8 * g) * 2);
                        const bf16x8 bb = *(const LAS bf16x8*)(L + G_KL + (16 * tj + fr) * 272 + (32 * ks + 8 * g) * 2);
                        acc = mfma16(a, bb, acc); }
                }
#pragma unroll
                for (int jj = 0; jj < 4; ++jj) { float v = acc[jj];
                    if (tj > ti || (tj == ti && fr > 4 * g + jj)) v = 0.f;
                    *(LAS unsigned short*)(L + G_PL + (16 * ti + 4 * g + jj) * 144 + (16 * tj + fr) * 2) = (unsigned short)(cvtpk(v, 0.f) & 0xffffu); }
            }
        }
        __syncthreads();
        f32x4 oacc[4][2];
#pragma unroll
        for (int ti = 0; ti < 4; ++ti) { oacc[ti][0] = (f32x4){0.f, 0.f, 0.f, 0.f}; oacc[ti][1] = (f32x4){0.f, 0.f, 0.f, 0.f}; }
        bf16x8 vB[2][2];
#pragma unroll
        for (int ks = 0; ks < 2; ++ks)
#pragma unroll
            for (int dvi = 0; dvi < 2; ++dvi) { const LAS unsigned char* ap = L + G_VL + (32 * ks + 8 * g + (fr >> 2)) * 528 + (32 * wave + 16 * dvi + 4 * (fr & 3)) * 2;
                vB[ks][dvi] = cat8(vtr(ap), vtr(ap + 4 * 528)); }
#pragma unroll
        for (int ti = 0; ti < 4; ++ti)
#pragma unroll
            for (int ks = 0; ks < 2; ++ks) { if (32 * ks > 16 * ti + 15) continue;
                const bf16x8 a = *(const LAS bf16x8*)(L + G_PL + (16 * ti + fr) * 144 + (32 * ks + 8 * g) * 2);
                oacc[ti][0] = mfma16(a, vB[ks][0], oacc[ti][0]); oacc[ti][1] = mfma16(a, vB[ks][1], oacc[ti][1]); }
        __builtin_amdgcn_sched_barrier(0);
#pragma unroll
        for (int ks = 0; ks < 4; ++ks) {
#pragma unroll
            for (int ti = 0; ti < 4; ++ti) {
                const s16x4 qa = *(const LAS s16x4*)(L + G_QL + (16 * ti + fr) * 272 + (32 * ks + 4 * g) * 2);
                const s16x4 qb = *(const LAS s16x4*)(L + G_QL + (16 * ti + fr) * 272 + (32 * ks + 16 + 4 * g) * 2);
                const bf16x8 a = cat8(qa, qb);
                oacc[ti][0] = mfma16(a, sbf[ks][0], oacc[ti][0]); oacc[ti][1] = mfma16(a, sbf[ks][1], oacc[ti][1]); }
        }
        __builtin_amdgcn_sched_barrier(0);
#pragma unroll
        for (int ti = 0; ti < 4; ++ti)
#pragma unroll
            for (int jj = 0; jj < 4; ++jj) { float s = oacc[ti][0][jj] * oacc[ti][0][jj] + oacc[ti][1][jj] * oacc[ti][1][jj];
                s += __shfl_xor(s, 1); s += __shfl_xor(s, 2); s += __shfl_xor(s, 4); s += __shfl_xor(s, 8);
                if (fr == 0) *(LAS float*)(L + G_SS + ((16 * ti + 4 * g + jj) * 8 + wave) * 4) = s; }
        __syncthreads();
#pragma unroll
        for (int ti = 0; ti < 4; ++ti)
#pragma unroll
            for (int jj = 0; jj < 4; ++jj) { const int tok = 16 * ti + 4 * g + jj;
                const f32x4 sa = *(const LAS f32x4*)(L + G_SS + tok * 32), sb = *(const LAS f32x4*)(L + G_SS + tok * 32 + 16);
                const float tot = ((sa.x + sa.y) + (sa.z + sa.w)) + ((sb.x + sb.y) + (sb.z + sb.w));
                const float rstd = 1.0f / sqrtf(tot * (1.0f / 256.0f) + EPS);
                *(LAS unsigned short*)(L + G_OL + tok * 528 + (32 * wave + fr) * 2) = (unsigned short)(cvtpk(oacc[ti][0][jj] * rstd * gn0, 0.f) & 0xffffu);
                *(LAS unsigned short*)(L + G_OL + tok * 528 + (32 * wave + 16 + fr) * 2) = (unsigned short)(cvtpk(oacc[ti][1][jj] * rstd * gn1, 0.f) & 0xffffu); }
        __syncthreads();
#pragma unroll
        for (int i = 0; i < 4; ++i) { const int ci = tid + 512 * i, row = ci >> 5, cc = ci & 31;
            const u32x4 ov = *(const LAS u32x4*)(L + G_OL + row * 528 + cc * 16); const u32x4 rv = prg[i]; u32x4 w;
#pragma unroll
            for (int e = 0; e < 4; ++e) { const float r0 = bflo(rv[e]), r1 = bfhi(rv[e]);
                const float s0 = r0 * __builtin_amdgcn_rcpf(1.0f + fexp(-r0)), s1 = r1 * __builtin_amdgcn_rcpf(1.0f + fexp(-r1));
                w[e] = cvtpk(bflo(ov[e]) * s0, bfhi(ov[e]) * s1); }
            *(u32x4*)(OA + (m0 + row) * DM + h * 256 + 8 * cc) = w; }
}

__device__ __forceinline__ void attn_units(const Params& p, LAS unsigned char* buf, int sel, int wave) {
    const bf16_t* QKVC = (const bf16_t*)(p.ws + WS_QKVC);
    bf16_t* OBR = (bf16_t*)(p.ws + WS_OBR); float* LSE = (float*)(p.ws + WS_LSE);
    bf16_t* OA = (bf16_t*)(p.ws + WS_XN);
    int lane = hw_lane(), tid = wave * 64 + lane, fr = lane & 15, g = lane >> 4;
    const int G = gridDim.x, total = sel == 0 ? 1024 : 512;
    const int nk = ((int)blockIdx.x < total) ? (total - (int)blockIdx.x + G - 1) / G : 0;
    if (nk == 0) return;
    int ub, uh, ur, urho, un, uslot;
#define AU_DECODE(U_) do { int U = (U_); int bh; if (sel == 0) { if (U < 512) { bh = U >> 4; un = U & 15; ur = 1; urho = 0; uslot = 0; } \
            else { U -= 512; bh = U >> 4; urho = (U >> 2) & 3; un = U & 3; ur = 4; uslot = 1; } } \
        else { bh = U >> 4; urho = U & 15; un = 0; ur = 16; uslot = 0; } ub = bh >> 3; uh = bh & 7; } while (0)
#define AU_KVLOAD(which) do { _Pragma("unroll") for (int i = 0; i < 12; ++i) { const int pc = tid + 512 * i, row = pc >> 4, cc = pc & 15; int j = 256 * un - 128 + row; j = j < 0 ? 0 : j; \
        kvreg[i] = *(const u32x4*)(QKVC + (size_t)(which) * QKV_ELEMS + ((size_t)(ub * 8 + uh) * SEQ + (size_t)j * ur + urho) * 128 + 8 * cc); } } while (0)
#define AU_QLOAD() do { _Pragma("unroll") for (int qt = 0; qt < 2; ++qt) { const bf16_t* qp = QKVC + ((size_t)(ub * 8 + uh) * SEQ + (size_t)(256 * un + 32 * wave + 16 * qt + fr) * ur + urho) * 128 + 8 * g; \
        _Pragma("unroll") for (int ks = 0; ks < 4; ++ks) qf[qt][ks] = *(const bf16x8*)(qp + 32 * ks); } } while (0)
    u32x4 kvreg[12]; bf16x8 qf[2][4];
    AU_DECODE((int)blockIdx.x);
    AU_KVLOAD(1);
#pragma unroll 1
    for (int k = 0; k < nk; ++k) {
        lane = hw_lane(); tid = wave * 64 + lane; fr = lane & 15; g = lane >> 4;
        const int b = ub, h = uh, r = ur, rho = urho, n = un, slot = uslot;
        const size_t rb = (size_t)b * SEQ; const int i0 = 256 * n + 32 * wave;
        __syncthreads();
        AU_QLOAD();
#pragma unroll
        for (int i = 0; i < 12; ++i) { const int pc = tid + 512 * i, row = pc >> 4, cc = pc & 15; *(LAS u32x4*)(buf + row * 272 + cc * 16) = kvreg[i]; }
        __syncthreads();
        f32x4 sc[10][2];
#pragma unroll
        for (int kt = 0; kt < 10; ++kt) {
            bf16x8 kfr[4];
#pragma unroll
            for (int ks = 0; ks < 4; ++ks) kfr[ks] = *(const LAS bf16x8*)(buf + (32 * wave + 16 * kt + fr) * 272 + (32 * ks + 8 * g) * 2);
#pragma unroll
            for (int qt = 0; qt < 2; ++qt) { f32x4 a = (f32x4){0.f, 0.f, 0.f, 0.f};
#pragma unroll
                for (int ks = 0; ks < 4; ++ks) a = mfma16(kfr[ks], qf[qt][ks], a);
                sc[kt][qt] = a; } }
        __builtin_amdgcn_sched_barrier(0);
        AU_KVLOAD(2);
        __builtin_amdgcn_sched_barrier(0);
        float mq[2], lq[2];
#pragma unroll
        for (int qt = 0; qt < 2; ++qt) { float mx = -INFINITY;
#pragma unroll
            for (int kt = 0; kt < 10; ++kt)
#pragma unroll
                for (int jj = 0; jj < 4; ++jj) { const int dist = 128 + 16 * (qt - kt) + fr - 4 * g - jj, jk = i0 - 128 + 16 * kt + 4 * g + jj;
                    const bool ok = (dist >= 0) && (dist <= 128) && (jk >= 0);
                    const float v = ok ? sc[kt][qt][jj] : -INFINITY; sc[kt][qt][jj] = v; mx = fmaxf(mx, v); }
            mx = fmaxf(mx, __shfl_xor(mx, 16)); mx = fmaxf(mx, __shfl_xor(mx, 32));
            float l = 0.f;
#pragma unroll
            for (int kt = 0; kt < 10; ++kt)
#pragma unroll
                for (int jj = 0; jj < 4; ++jj) { const float e = __builtin_amdgcn_exp2f(sc[kt][qt][jj] - mx); sc[kt][qt][jj] = e; l += e; }
            l += __shfl_xor(l, 16); l += __shfl_xor(l, 32);
            mq[qt] = mx; lq[qt] = l; }
        bf16x8 pf[5][2];
#pragma unroll
        for (int kk = 0; kk < 5; ++kk) { pf[kk][0] = pack8(sc[2 * kk][0], sc[2 * kk + 1][0]); pf[kk][1] = pack8(sc[2 * kk][1], sc[2 * kk + 1][1]); }
        __syncthreads();
#pragma unroll
        for (int i = 0; i < 12; ++i) { const int pc = tid + 512 * i, row = pc >> 4, cc = pc & 15; *(LAS u32x4*)(buf + row * 288 + cc * 16) = kvreg[i]; }
        __syncthreads();
        if (k + 1 < nk) { AU_DECODE((int)blockIdx.x + G * (k + 1)); AU_KVLOAD(1); }
        f32x4 oacc[8][2];
#pragma unroll
        for (int d = 0; d < 8; ++d) { oacc[d][0] = (f32x4){0.f, 0.f, 0.f, 0.f}; oacc[d][1] = (f32x4){0.f, 0.f, 0.f, 0.f}; }
#pragma unroll
        for (int kk = 0; kk < 5; ++kk) {
#pragma unroll
            for (int d = 0; d < 8; ++d) { const LAS unsigned char* ap = buf + (32 * wave + 32 * kk + 4 * g + (fr >> 2)) * 288 + (16 * d + 4 * (fr & 3)) * 2;
                const bf16x8 vf = cat8(vtr(ap), vtr(ap + 16 * 288));
                oacc[d][0] = mfma16(vf, pf[kk][0], oacc[d][0]); oacc[d][1] = mfma16(vf, pf[kk][1], oacc[d][1]); }
        }
#pragma unroll
        for (int qt = 0; qt < 2; ++qt) {
            const size_t m = rb + (size_t)(i0 + 16 * qt + fr) * r + rho;
            const float inv = 1.0f / lq[qt], lse = mq[qt] + log2f(lq[qt]);
            if (sel == 0) {
                if (g == 0) LSE[(size_t)slot * MTOK * 8 + m * 8 + h] = lse;
#pragma unroll
                for (int d = 0; d < 8; ++d) { const f32x4 o = oacc[d][qt] * inv; u32x2 w; w.x = cvtpk(o[0], o[1]); w.y = cvtpk(o[2], o[3]);
                    *(u32x2*)(OBR + (size_t)slot * MTOK * 1024 + m * 1024 + h * 128 + 16 * d + 4 * g) = w; }
            } else {
                const float l0 = LSE[m * 8 + h], l1 = LSE[(size_t)MTOK * 8 + m * 8 + h];
                const float M = fmaxf(fmaxf(l0, l1), lse);
                const float w0 = __builtin_amdgcn_exp2f(l0 - M), w1 = __builtin_amdgcn_exp2f(l1 - M), w2 = __builtin_amdgcn_exp2f(lse - M);
                const float wi = 1.0f / (w0 + w1 + w2), a0 = w0 * wi, a1 = w1 * wi, a2 = w2 * wi * inv;
#pragma unroll
                for (int d = 0; d < 8; ++d) { const size_t off = m * 1024 + h * 128 + 16 * d + 4 * g;
                    const u32x2 x0 = *(const u32x2*)(OBR + off), x1 = *(const u32x2*)(OBR + (size_t)MTOK * 1024 + off);
                    const f32x4 o = oacc[d][qt];
                    const float r0 = a0 * bflo(x0.x) + a1 * bflo(x1.x) + a2 * o[0], r1 = a0 * bfhi(x0.x) + a1 * bfhi(x1.x) + a2 * o[1];
                    const float r2 = a0 * bflo(x0.y) + a1 * bflo(x1.y) + a2 * o[2], r3 = a0 * bfhi(x0.y) + a1 * bfhi(x1.y) + a2 * o[3];
                    u32x2 w; w.x = cvtpk(r0, r1); w.y = cvtpk(r2, r3);
                    *(u32x2*)(OA + m * DM + 1024 + h * 128 + 16 * d + 4 * g) = w; }
            }
        }
    }
    __syncthreads();
#undef AU_DECODE
#undef AU_KVLOAD
#undef AU_QLOAD
}

__global__ void __launch_bounds__(512) fwd_kernel(Params p) {
    extern __shared__ __attribute__((aligned(16))) unsigned char lds_raw[];
    LAS unsigned char* lds = (LAS unsigned char*)lds_raw;
    cg::grid_group grid = cg::this_grid();
    const int tid = threadIdx.x, lane = tid & 63, wave = __builtin_amdgcn_readfirstlane(tid >> 6);
    const int gw = blockIdx.x * 8 + wave, NGW = gridDim.x * 8, G = gridDim.x;
    bf16_t* wgu1 = (bf16_t*)(p.ws + WS_WGU1); bf16_t* wd1 = (bf16_t*)(p.ws + WS_WD1); bf16_t* win = (bf16_t*)(p.ws + WS_WIN); bf16_t* wout = (bf16_t*)(p.ws + WS_WOUT);
    bf16_t* wgu2 = (bf16_t*)(p.ws + WS_WGU2); bf16_t* wd2 = (bf16_t*)(p.ws + WS_WD2);
    bf16_t* XN = (bf16_t*)(p.ws + WS_XN); bf16_t* HZ = (bf16_t*)(p.ws + WS_HZ);

    const bool leader = (wave == 0) && (hw_lane() == 0);
    volatile LAS unsigned* bst = (volatile LAS unsigned*)(lds + LDS_BYTES - 16);
    if (leader) { bst[0] = 0u; bst[1] = 0u; }
    __syncthreads();
    const XcdBarrier xbar = xcd_barrier_post((unsigned*)(p.ws + WS_BAR), bst, leader);
    if (p.ws == nullptr) grid.sync();
    phase_prologue(p, lds, wave, lane);
    xcd_barrier(xbar, leader);
    float* rss1 = (float*)(p.ws + WS_RS); float* rss2 = rss1 + MTOK;
    { pg8::Gemm g{XN, wgu1, MTOK, 2 * FF, DM}; pg8::StaticOrder S; S.init(MTOK, 2 * FF, G, (int)blockIdx.x); pg8::EpiSwiGLU E{HZ, FF, nullptr};
      const bool stag = (G == 256), early = (((int)blockIdx.x >> 3) & 1) == 0;
      if (stag && early) { convert_items(p, (LAS float*)(lds + wave * 16384), hw_lane(), TR_I_GU + gw, TR_NITEMS, NGW); __syncthreads(); }
      pg8::gemm_phase<pg8::EpiSwiGLU, pg8::StaticOrder, true, true>(lds, g, S, E, wave);
      if (stag && !early) { __syncthreads(); convert_items(p, (LAS float*)(lds + wave * 16384), hw_lane(), TR_I_GU + gw, TR_NITEMS, NGW); } }
    xcd_barrier(xbar, leader);
    bf16_t* X1B = (bf16_t*)p.out;
    { pg8::Gemm g{HZ, wd1, MTOK, DM, FF}; pg8::StaticOrder S; S.init(MTOK, DM, G, (int)blockIdx.x); pg8::EpiResidNorm<false> E{p.x, X1B, rss1, DM, 0.5f};
      pg8::gemm_phase<pg8::EpiResidNorm<false>, pg8::StaticOrder, true, true>(lds, g, S, E, wave); }
    xcd_barrier(xbar, leader);
    { pg8::Gemm g{X1B, win, MTOK, 6144, DM}; pg8::StaticOrder S; S.init(MTOK, 6144, G, (int)blockIdx.x); pg8::EpiBf16 E{HZ, ZP, rss1, (bf16_t*)(p.ws + WS_QKVC)};
      pg8::gemm_phase<pg8::EpiBf16, pg8::StaticOrder, true, true>(lds, g, S, E, wave); }
    xcd_barrier(xbar, leader);
    phase_qkrope_gla_prep(p, lds, wave, lane);
    xcd_barrier(xbar, leader);
    for (int it = (int)blockIdx.x; it < 1024; it += G) gla_passA(p, lds, it, wave, lane);
    __syncthreads();
    attn_units(p, lds, 0, wave);
    xcd_barrier(xbar, leader);
    gla_scan(p, lds, wave);
    xcd_barrier(xbar, leader);
    for (int it = (int)blockIdx.x; it < 1024; it += G) gla_passC(p, lds, it, wave, lane);
    __syncthreads();
    attn_units(p, lds, 1, wave);
    xcd_barrier(xbar, leader);
    { pg8::Gemm g{XN, wout, MTOK, DM, DM}; pg8::StaticOrder S; S.init(MTOK, DM, G, (int)blockIdx.x); pg8::EpiResidNorm<true> E{X1B, (bf16_t*)(p.ws + WS_XN2), rss2, DM, 1.0f};
      pg8::gemm_phase<pg8::EpiResidNorm<true>, pg8::StaticOrder, true, true>(lds, g, S, E, wave); }
    xcd_barrier(xbar, leader);
    { pg8::Gemm g{(bf16_t*)(p.ws + WS_XN2), wgu2, MTOK, 2 * FF, DM}; pg8::StaticOrder S; S.init(MTOK, 2 * FF, G, (int)blockIdx.x); pg8::EpiSwiGLU E{HZ, FF, rss2};
      pg8::gemm_phase<pg8::EpiSwiGLU, pg8::StaticOrder, true, true>(lds, g, S, E, wave); }
    xcd_barrier(xbar, leader);
    { pg8::Gemm g{HZ, wd2, MTOK, DM, FF}; pg8::StaticOrder S; S.init(MTOK, DM, G, (int)blockIdx.x); pg8::EpiResid E{(const bf16_t*)(p.ws + WS_XN2), p.out, DM, 0.5f};
      pg8::gemm_phase<pg8::EpiResid, pg8::StaticOrder, true, true>(lds, g, S, E, wave); }
}

extern "C" void kernel_launch(void* const* d_in, const int* in_sizes, int n_in, void* d_out, int out_size, void* d_ws, size_t ws_size, hipStream_t stream) {
    static int grid = 0;
    if (grid == 0) {
        if (n_in != 17 || out_size != MTOK * DM || ws_size < WS_END) { fprintf(stderr, "kernel_launch: unexpected shapes (n_in %d out %d ws %zu)\n", n_in, out_size, ws_size); grid = -1; return; }
        int dev = 0, cus = 0, per_cu = 0;
        (void)hipGetDevice(&dev); (void)hipDeviceGetAttribute(&cus, hipDeviceAttributeMultiprocessorCount, dev);
        if (hipFuncSetAttribute((const void*)fwd_kernel, hipFuncAttributeMaxDynamicSharedMemorySize, LDS_BYTES) != hipSuccess) { fprintf(stderr, "kernel_launch: hipFuncSetAttribute failed\n"); grid = -1; return; }
        if (hipOccupancyMaxActiveBlocksPerMultiprocessor(&per_cu, (const void*)fwd_kernel, 512, LDS_BYTES) != hipSuccess || per_cu < 1) { fprintf(stderr, "kernel_launch: occupancy query gave %d\n", per_cu); per_cu = 1; (void)hipGetLastError(); }
        grid = cus * per_cu;
    }
    if (grid < 0) return;
    Params p{};
    p.x = (const float*)d_in[0]; p.n1 = (const float*)d_in[1]; p.wg1 = (const float*)d_in[2]; p.wu1 = (const float*)d_in[3]; p.wd1 = (const float*)d_in[4];
    p.nmix = (const float*)d_in[5]; p.win = (const float*)d_in[6]; p.gup = (const float*)d_in[7]; p.gbias = (const float*)d_in[8]; p.gonorm = (const float*)d_in[9];
    p.qn = (const float*)d_in[10]; p.kn = (const float*)d_in[11]; p.wout = (const float*)d_in[12]; p.n2 = (const float*)d_in[13];
    p.wg2 = (const float*)d_in[14]; p.wu2 = (const float*)d_in[15]; p.wd2 = (const float*)d_in[16];
    p.out = (float*)d_out; p.ws = (unsigned char*)d_ws;
    (void)hipMemsetAsync((char*)d_ws + WS_BAR, 0, 16384, stream);
    void* args[] = {&p};
    hipError_t e = hipLaunchCooperativeKernel((const void*)fwd_kernel, dim3(grid), dim3(512), args, LDS_BYTES, stream);
    if (e != hipSuccess) fprintf(stderr, "kernel_launch: cooperative launch failed: %s (grid %d)\n", hipGetErrorString(e), grid);
}
```

```cpp
#include <hip/hip_runtime.h>
#include <hip/hip_cooperative_groups.h>
#include <cstdio>
#include <cstdint>
namespace cg = cooperative_groups;

namespace pg8 {
#define PG8_LAS __attribute__((address_space(3)))
typedef unsigned short bf16_t;
typedef short bf16x8 __attribute__((ext_vector_type(8)));
typedef float f32x4 __attribute__((ext_vector_type(4)));
typedef unsigned u32x4 __attribute__((ext_vector_type(4)));
constexpr int BM = 256, BK = 64, HALF = 128, HTB = HALF * BK * 2  , STAGE_BYTES = 8 * HTB, NXCD = 8, WGM = 8;

__host__ __device__ __forceinline__ int lds_byte(int r, int c) { const int st = (r >> 4) * 2 + (c >> 5), rr = r & 15, cc = c & 31, ob = rr * 64 + cc * 2; return st * 1024 + (ob ^ (((ob >> 9) & 1) << 5)); }
__host__ __device__ __forceinline__ void stage_rc(int b, int& R, int& C) { const int st = b / 1024, sb = b % 1024, swz = sb ^ (((sb >> 9) & 1) << 5); R = (st >> 1) * 16 + swz / 64; C = (st & 1) * 32 + (swz % 64) / 2; }
__host__ __device__ __forceinline__ int perm32(int rho) { const int n = rho >> 4, i = rho & 15; return 8 * (i >> 2) + 4 * n + (i & 3); }

struct Unit { int pm, pn; };
struct Gemm { const bf16_t* A; const bf16_t* Bt; int M, N, K; };

struct StaticOrder {
    int nM, nN, nwg, G, c;
    __host__ __device__ void init(int M, int N, int G_, int c_) { nM = M / BM; nN = N / BM; nwg = nM * nN; G = G_; c = c_; }
    __host__ __device__ bool next(int i, Unit& u) const {
        const long L = (long)i * G + c; if (L >= nwg) return false;
        int wgid = (int)L; { const int q = nwg / NXCD, r = nwg % NXCD, xcd = wgid % NXCD, off = wgid / NXCD; wgid = (xcd < r ? xcd * (q + 1) : r * (q + 1) + (xcd - r) * q) + off; }
        const int nig = WGM * nN, gid = wgid / nig, fm = gid * WGM, gsz = (nM - fm) < WGM ? (nM - fm) : WGM;
        u.pm = fm + ((wgid % nig) % gsz); u.pn = (wgid % nig) / gsz; return true;
    }
    __device__ __forceinline__ void a_ready(const Unit&) const {}
    __device__ __forceinline__ void done(const Unit&) const {}
};

struct SplitOrder {
    int nM, nN, nwg, first, stride, count;
    __host__ __device__ void init(int M, int N, int first_, int stride_, int count_) { nM = M / BM; nN = N / BM; nwg = nM * nN; first = first_; stride = stride_; count = count_; }
    __host__ __device__ bool next(int i, Unit& u) const {
        if (i >= count) return false;
        const long L = (long)i * stride + first; if (L >= nwg) return false;
        int wgid = (int)L; { const int q = nwg / NXCD, r = nwg % NXCD, xcd = wgid % NXCD, off = wgid / NXCD; wgid = (xcd < r ? xcd * (q + 1) : r * (q + 1) + (xcd - r) * q) + off; }
        const int nig = WGM * nN, gid = wgid / nig, fm = gid * WGM, gsz = (nM - fm) < WGM ? (nM - fm) : WGM;
        u.pm = fm + ((wgid % nig) % gsz); u.pn = (wgid % nig) / gsz; return true;
    }
    __device__ __forceinline__ void a_ready(const Unit&) const {}
    __device__ __forceinline__ void done(const Unit&) const {}
};

__device__ __forceinline__ unsigned cvt_pk_bf16(float lo, float hi) { unsigned r; asm volatile("v_cvt_pk_bf16_f32 %0, %1, %2" : "=v"(r) : "v"(lo), "v"(hi)); return r; }
typedef float f32x2 __attribute__((ext_vector_type(2)));
__device__ __forceinline__ float silu_f(float g) { return g * __builtin_amdgcn_rcpf(1.0f + __builtin_amdgcn_exp2f(-1.44269504089f * g)); }

struct EpiBf16 {
    static constexpr bool PERM = true, AFTER_DRAIN = false;
    bf16_t* O; int ldc; const float* rowss; bf16_t* QKVC;
    __device__ __forceinline__ void pre(const Unit& u, int wr, int fr, float (&pv)[8]) const {
#pragma unroll
        for (int ai = 0; ai < 2; ++ai)
#pragma unroll
            for (int m = 0; m < 4; ++m) pv[ai * 4 + m] = rowss[u.pm * BM + wr * 64 + fr + ai * HALF + m * 16];
    }
    __device__ __forceinline__ void operator()(const f32x4 (&acc)[2][2][4][2], const Unit& u, int wr, int wc, int fr, int fq, const float (&pv)[8]) const {
        const int row0 = u.pm * BM + wr * 64 + fr; const int cw = wc * 32 + 8 * fq;
#pragma unroll
        for (int ai = 0; ai < 2; ++ai)
#pragma unroll
            for (int m = 0; m < 4; ++m) { const int row = row0 + ai * HALF + m * 16;
                const float rs = 1.0f / sqrtf(pv[ai * 4 + m] * (1.0f / 2048.0f) + 1e-6f);
#pragma unroll
                for (int bj = 0; bj < 2; ++bj) { const f32x4 v0 = acc[ai][bj][m][0] * rs, v1 = acc[ai][bj][m][1] * rs;
                    u32x4 w; w.x = cvt_pk_bf16(v0[0], v0[1]); w.y = cvt_pk_bf16(v0[2], v0[3]); w.z = cvt_pk_bf16(v1[0], v1[1]); w.w = cvt_pk_bf16(v1[2], v1[3]);
                    const int cb = u.pn * BM + bj * HALF;
                    bf16_t* dst;
                    if (cb < 3072) dst = O + (size_t)row * ldc + cb + cw;
                    else { const int idx = (cb - 3072) >> 7, which = idx >> 3, head = idx & 7;
                        dst = QKVC + (size_t)which * ((size_t)16384 * 1024) + ((size_t)((row >> 12) * 8 + head) * 4096 + (row & 4095)) * 128 + cw; }
                    *(u32x4*)dst = w; } }
    }
};
struct EpiSwiGLU {
    static constexpr bool PERM = true, AFTER_DRAIN = false;
    bf16_t* O; int ldc; const float* rowss;
    __device__ __forceinline__ void pre(const Unit& u, int wr, int fr, float (&pv)[8]) const {
#pragma unroll
        for (int ai = 0; ai < 2; ++ai)
#pragma unroll
            for (int m = 0; m < 4; ++m) pv[ai * 4 + m] = rowss ? rowss[u.pm * BM + wr * 64 + fr + ai * HALF + m * 16] : 0.f;
    }
    __device__ __forceinline__ void operator()(const f32x4 (&acc)[2][2][4][2], const Unit& u, int wr, int wc, int fr, int fq, const float (&pv)[8]) const {
        const int row0 = u.pm * BM + wr * 64 + fr; const int col0 = u.pn * HALF + wc * 32 + 8 * fq;
#pragma unroll
        for (int ai = 0; ai < 2; ++ai)
#pragma unroll
            for (int m = 0; m < 4; ++m) { bf16_t* rowp = O + (size_t)(row0 + ai * HALF + m * 16) * ldc + col0;
                const float rs = rowss ? 1.0f / sqrtf(pv[ai * 4 + m] * (1.0f / 2048.0f) + 1e-6f) : 1.0f;
                const f32x4 g0 = acc[ai][0][m][0] * rs, g1 = acc[ai][0][m][1] * rs, u0 = acc[ai][1][m][0] * rs, u1 = acc[ai][1][m][1] * rs;
                float h[8];
#pragma unroll
                for (int j = 0; j < 4; ++j) { h[j] = silu_f(g0[j]) * u0[j]; h[4 + j] = silu_f(g1[j]) * u1[j]; }
                u32x4 w; w.x = cvt_pk_bf16(h[0], h[1]); w.y = cvt_pk_bf16(h[2], h[3]); w.z = cvt_pk_bf16(h[4], h[5]); w.w = cvt_pk_bf16(h[6], h[7]);
                *(u32x4*)rowp = w; }
    }
};
template <bool BASE_BF16> struct EpiResidNorm {
    static constexpr bool PERM = false, AFTER_DRAIN = false;
    const void* base; bf16_t* xn; float* rowss; int ldc; float scale;
    __device__ __forceinline__ void pre(const Unit&, int, int, float (&)[8]) const {}
    __device__ __forceinline__ void operator()(const f32x4 (&acc)[2][2][4][2], const Unit& u, int wr, int wc, int fr, int fq, const float (&)[8]) const {
        typedef unsigned u32x2 __attribute__((ext_vector_type(2)));
        const int col0 = u.pn * BM + wc * 32 + 4 * fq;
#pragma unroll
        for (int ai = 0; ai < 2; ++ai)
#pragma unroll
            for (int m = 0; m < 4; ++m) { const int row = u.pm * BM + ai * HALF + wr * 64 + m * 16 + fr; const size_t off = (size_t)row * ldc + col0;
                float ss = 0.f;
#pragma unroll
                for (int bj = 0; bj < 2; ++bj)
#pragma unroll
                    for (int n = 0; n < 2; ++n) { f32x4 bs;
                        if (BASE_BF16) { const u32x2 t = *(const u32x2*)((const bf16_t*)base + off + bj * HALF + n * 16);
                            bs = (f32x4){__builtin_bit_cast(float, t.x << 16), __builtin_bit_cast(float, t.x & 0xffff0000u), __builtin_bit_cast(float, t.y << 16), __builtin_bit_cast(float, t.y & 0xffff0000u)}; }
                        else bs = *(const f32x4*)((const float*)base + off + bj * HALF + n * 16);
                        const f32x4 v = bs + acc[ai][bj][m][n] * scale;
                        u32x2 w; w.x = cvt_pk_bf16(v[0], v[1]); w.y = cvt_pk_bf16(v[2], v[3]);
                        *(u32x2*)(xn + off + bj * HALF + n * 16) = w;
                        ss += (v[0] * v[0] + v[1] * v[1]) + (v[2] * v[2] + v[3] * v[3]); }
                ss += __shfl_xor(ss, 16); ss += __shfl_xor(ss, 32);
                if (fq == 0) __hip_atomic_fetch_add(rowss + row, ss, __ATOMIC_RELAXED, __HIP_MEMORY_SCOPE_AGENT); }
    }
};
struct EpiResid {
    static constexpr bool PERM = false, AFTER_DRAIN = false;
    const bf16_t* base; float* out; int ldc; float scale;
    __device__ __forceinline__ void pre(const Unit&, int, int, float (&)[8]) const {}
    __device__ __forceinline__ void operator()(const f32x4 (&acc)[2][2][4][2], const Unit& u, int wr, int wc, int fr, int fq, const float (&)[8]) const {
        typedef unsigned u32x2 __attribute__((ext_vector_type(2)));
        const int col0 = u.pn * BM + wc * 32 + 4 * fq;
#pragma unroll
        for (int ai = 0; ai < 2; ++ai)
#pragma unroll
            for (int m = 0; m < 4; ++m) { const size_t off = (size_t)(u.pm * BM + ai * HALF + wr * 64 + m * 16 + fr) * ldc + col0;
#pragma unroll
                for (int bj = 0; bj < 2; ++bj)
#pragma unroll
                    for (int n = 0; n < 2; ++n) { const u32x2 t = *(const u32x2*)(base + off + bj * HALF + n * 16);
                        const f32x4 bs = (f32x4){__builtin_bit_cast(float, t.x << 16), __builtin_bit_cast(float, t.x & 0xffff0000u), __builtin_bit_cast(float, t.y << 16), __builtin_bit_cast(float, t.y & 0xffff0000u)};
                        *(f32x4*)(out + off + bj * HALF + n * 16) = bs + acc[ai][bj][m][n] * scale; } }
    }
};

template <class Epi, class Sched, bool ALIGN_EPI = false, bool SP2 = false>
__device__ __forceinline__ void gemm_phase(PG8_LAS unsigned char* lds, const Gemm g, const Sched& S, const Epi& E, int wave_in) {
    int tid_; { int l_; asm volatile("v_mbcnt_lo_u32_b32 %0, -1, 0\n\tv_mbcnt_hi_u32_b32 %0, -1, %0" : "=v"(l_)); tid_ = wave_in * 64 + l_; }
    const int tid = tid_, wid = __builtin_amdgcn_readfirstlane(tid >> 6), lane = tid & 63, wr = wid >> 2, wc = wid & 3, fr = lane & 15, fq = lane >> 4;
    const int K = g.K, nt = K / BK;
    unsigned voffA[2], voffB[2];
#pragma unroll
    for (int i = 0; i < 2; ++i) { int R, C; stage_rc(tid * 16 + i * 8192, R, C); const int Rb = Epi::PERM ? ((R & ~31) + perm32(R & 31)) : R;
        voffA[i] = (unsigned)(R * K + C) * 2u; voffB[i] = (unsigned)(Rb * K + C) * 2u; }
    const size_t kstep = (size_t)(BK * 2);
    const size_t hstep = (size_t)HALF * K * 2;
    const size_t tstep = 2 * hstep;
    const unsigned ldsw = (unsigned)wid * 1024u;
    const int aoff = lds_byte(wr * 64 + fr, fq * 8), boff = lds_byte(wc * 32 + fr, fq * 8);
#define PG8_SA(b, h) (((b) * 2 + (h)) * HTB)
#define PG8_SB(b, h) ((4 + (b) * 2 + (h)) * HTB)
#define PG8_STAGE(bufoff, gbase, voff) do { _Pragma("unroll") for (int _i = 0; _i < 2; ++_i) \
        __builtin_amdgcn_global_load_lds((const unsigned*)((const char*)(gbase) + (voff)[_i]), (PG8_LAS unsigned*)(lds + (bufoff) + ldsw + _i * 8192), 16, 0, 0); } while (0)
#define PG8_LDA(dst, b, h) do { _Pragma("unroll") for (int m = 0; m < 4; ++m) _Pragma("unroll") for (int k = 0; k < 2; ++k) dst[m][k] = *(const PG8_LAS bf16x8*)(lds + PG8_SA(b, h) + aoff + m * 2048 + k * 1024); } while (0)
#define PG8_LDB(dst, b, h) do { _Pragma("unroll") for (int n = 0; n < 2; ++n) _Pragma("unroll") for (int k = 0; k < 2; ++k) dst[n][k] = *(const PG8_LAS bf16x8*)(lds + PG8_SB(b, h) + boff + n * 2048 + k * 1024); } while (0)
#define PG8_MMA(ai, bj, At, Bt) do { __builtin_amdgcn_s_setprio(1); _Pragma("unroll") for (int m = 0; m < 4; ++m) _Pragma("unroll") for (int n = 0; n < 2; ++n) _Pragma("unroll") for (int k = 0; k < 2; ++k) \
        acc[ai][bj][m][n] = __builtin_amdgcn_mfma_f32_16x16x32_bf16(Bt[n][k], At[m][k], acc[ai][bj][m][n], 0, 0, 0); __builtin_amdgcn_s_setprio(0); } while (0)
#define PG8_WAIT_V(n) asm volatile("s_waitcnt vmcnt(" #n ")" ::: "memory")
#define PG8_WAIT_L(n) asm volatile("s_waitcnt lgkmcnt(" #n ")" ::: "memory")
#define PG8_BAR __builtin_amdgcn_s_barrier()
#define PG8_SCHED __builtin_amdgcn_sched_barrier(0)
    Unit cur, nxt; int ui = 0;
    if (!S.next(0, cur)) return;
    f32x4 acc[2][2][4][2];
#pragma unroll
    for (int a = 0; a < 2; ++a)
#pragma unroll
        for (int b = 0; b < 2; ++b)
#pragma unroll
            for (int m = 0; m < 4; ++m)
#pragma unroll
                for (int n = 0; n < 2; ++n) acc[a][b][m][n] = (f32x4){0.f, 0.f, 0.f, 0.f};
    bf16x8 At[4][2], B0[2][2], B1[2][2];
    const char* cA = (const char*)g.A + (size_t)cur.pm * tstep; const char* cB = (const char*)g.Bt + (size_t)cur.pn * tstep;
    S.a_ready(cur);
    if constexpr (SP2) {
        PG8_STAGE(PG8_SB(0, 0), cB, voffB); PG8_STAGE(PG8_SB(0, 1), cB + hstep, voffB); PG8_STAGE(PG8_SA(0, 0), cA, voffA); PG8_STAGE(PG8_SA(0, 1), cA + hstep, voffA);
        if (wr == 1) PG8_BAR;
        PG8_WAIT_V(2); PG8_BAR;
        PG8_STAGE(PG8_SB(1, 0), cB + kstep, voffB); PG8_STAGE(PG8_SA(1, 0), cA + kstep, voffA); PG8_STAGE(PG8_SB(1, 1), cB + hstep + kstep, voffB);
        PG8_WAIT_V(6); PG8_BAR;
    } else {
        PG8_STAGE(PG8_SB(0, 0), cB, voffB); PG8_STAGE(PG8_SA(0, 0), cA, voffA); PG8_STAGE(PG8_SB(0, 1), cB + hstep, voffB); PG8_STAGE(PG8_SA(0, 1), cA + hstep, voffA);
        if (wr == 1) PG8_BAR;
        PG8_WAIT_V(4); PG8_BAR;
        PG8_STAGE(PG8_SB(1, 0), cB + kstep, voffB); PG8_STAGE(PG8_SA(1, 0), cA + kstep, voffA); PG8_STAGE(PG8_SB(1, 1), cB + hstep + kstep, voffB);
        PG8_WAIT_V(6); PG8_BAR;
    }
    for (;;) {
        float pre[8]; E.pre(cur, wr, fr, pre);
        const bool has_next = S.next(ui + 1, nxt);
        const char* nA = has_next ? (const char*)g.A + (size_t)nxt.pm * tstep : cA; const char* nB = has_next ? (const char*)g.Bt + (size_t)nxt.pn * tstep : cB;
        for (int t = 0; t < nt; t += 2) {
            const bool last = (t == nt - 2);
            const char* a1 = cA + (size_t)(t + 1) * kstep;
            const char* a2 = last ? nA : cA + (size_t)(t + 2) * kstep; const char* b2 = last ? nB : cB + (size_t)(t + 2) * kstep;
            const char* a3 = a2 + kstep; const char* b3 = b2 + kstep;
            if (last && has_next) S.a_ready(nxt);
            if constexpr (SP2) {
            PG8_LDB(B0, 0, 0); PG8_LDB(B1, 0, 1); PG8_SCHED; PG8_LDA(At, 0, 0); PG8_STAGE(PG8_SA(1, 1), a1 + hstep, voffA);
            PG8_WAIT_V(8); PG8_WAIT_L(0); PG8_BAR; PG8_MMA(0, 0, At, B0); PG8_MMA(0, 1, At, B1); PG8_BAR; PG8_SCHED;
            PG8_LDA(At, 0, 1); PG8_STAGE(PG8_SB(0, 0), b2, voffB); PG8_STAGE(PG8_SB(0, 1), b2 + hstep, voffB); PG8_STAGE(PG8_SA(0, 0), a2, voffA);
            PG8_WAIT_V(8); PG8_WAIT_L(0); PG8_BAR; PG8_MMA(1, 0, At, B0); PG8_MMA(1, 1, At, B1); PG8_BAR; PG8_SCHED;
            PG8_LDB(B0, 1, 0); PG8_LDB(B1, 1, 1); PG8_SCHED; PG8_LDA(At, 1, 0); PG8_STAGE(PG8_SA(0, 1), a2 + hstep, voffA);
            PG8_WAIT_V(8); PG8_WAIT_L(0); PG8_BAR; PG8_MMA(0, 0, At, B0); PG8_MMA(0, 1, At, B1); PG8_BAR; PG8_SCHED;
            PG8_LDA(At, 1, 1); PG8_STAGE(PG8_SB(1, 0), b3, voffB); PG8_STAGE(PG8_SB(1, 1), b3 + hstep, voffB); PG8_STAGE(PG8_SA(1, 0), a3, voffA);
            PG8_WAIT_V(8); PG8_WAIT_L(0); PG8_BAR; PG8_MMA(1, 0, At, B0); PG8_MMA(1, 1, At, B1); PG8_BAR; PG8_SCHED;
            } else {
            PG8_LDB(B0, 0, 0); PG8_SCHED; PG8_LDA(At, 0, 0); PG8_STAGE(PG8_SA(1, 1), a1 + hstep, voffA);
            PG8_WAIT_L(8); PG8_BAR; PG8_WAIT_L(0); PG8_MMA(0, 0, At, B0); PG8_BAR; PG8_SCHED;
            PG8_LDB(B1, 0, 1); PG8_STAGE(PG8_SB(0, 0), b2, voffB);
            PG8_BAR; PG8_WAIT_L(0); PG8_MMA(0, 1, At, B1); PG8_BAR;
            PG8_LDA(At, 0, 1); PG8_STAGE(PG8_SA(0, 0), a2, voffA);
            PG8_BAR; PG8_WAIT_L(0); PG8_MMA(1, 0, At, B0); PG8_BAR; PG8_SCHED;
            PG8_STAGE(PG8_SB(0, 1), b2 + hstep, voffB);
            PG8_WAIT_V(6); PG8_BAR; PG8_MMA(1, 1, At, B1); PG8_BAR;
            PG8_LDB(B0, 1, 0); PG8_SCHED; PG8_LDA(At, 1, 0); PG8_STAGE(PG8_SA(0, 1), a2 + hstep, voffA);
            PG8_WAIT_L(8); PG8_BAR; PG8_WAIT_L(0); PG8_MMA(0, 0, At, B0); PG8_BAR; PG8_SCHED;
            PG8_LDB(B1, 1, 1); PG8_STAGE(PG8_SB(1, 0), b3, voffB);
            PG8_BAR; PG8_WAIT_L(0); PG8_MMA(0, 1, At, B1); PG8_BAR;
            PG8_LDA(At, 1, 1); PG8_STAGE(PG8_SA(1, 0), a3, voffA);
            PG8_BAR; PG8_WAIT_L(0); PG8_MMA(1, 0, At, B0); PG8_BAR; PG8_SCHED;
            PG8_STAGE(PG8_SB(1, 1), b3 + hstep, voffB);
            PG8_WAIT_V(6); PG8_BAR; PG8_MMA(1, 1, At, B1); PG8_BAR;
            }
        }
        if constexpr (ALIGN_EPI) { if (wr == 0) PG8_BAR; }
        if constexpr (!Epi::AFTER_DRAIN) { E(acc, cur, wr, wc, fr, fq, pre); S.done(cur); }
        if (!has_next) break;
#pragma unroll
        for (int a = 0; a < 2; ++a)
#pragma unroll
            for (int b = 0; b < 2; ++b)
#pragma unroll
                for (int m = 0; m < 4; ++m)
#pragma unroll
                    for (int n = 0; n < 2; ++n) acc[a][b][m][n] = (f32x4){0.f, 0.f, 0.f, 0.f};
        cur = nxt; cA = nA; cB = nB; ++ui;
        if constexpr (ALIGN_EPI) { if (wr == 1) PG8_BAR; }
    }
    PG8_WAIT_V(0);
    if constexpr (!ALIGN_EPI) { if (wr == 0) PG8_BAR; }
    PG8_BAR;
    if constexpr (Epi::AFTER_DRAIN) { E.fused(acc, cur, wr, wc, fr, fq, lds, wid, lane); S.done(cur); }
#undef PG8_SA
#undef PG8_SB
#undef PG8_STAGE
#undef PG8_LDA
#undef PG8_LDB
#undef PG8_MMA
#undef PG8_WAIT_V
#undef PG8_WAIT_L
#undef PG8_BAR
#undef PG8_SCHED
}
}
#define LAS __attribute__((address_space(3)))
typedef unsigned short bf16_t;
typedef short bf16x8 __attribute__((ext_vector_type(8)));
typedef short s16x4 __attribute__((ext_vector_type(4)));
typedef float f32x4 __attribute__((ext_vector_type(4)));
typedef float f32x2 __attribute__((ext_vector_type(2)));
typedef unsigned u32x4 __attribute__((ext_vector_type(4)));
typedef unsigned u32x2 __attribute__((ext_vector_type(2)));
typedef __bf16 bf16x2_t __attribute__((ext_vector_type(2)));

constexpr int NB = 4, SEQ = 4096, DM = 2048, FF = 5632, MTOK = NB * SEQ;
constexpr int ZP = 3072, DIN_SRC = 6160;
constexpr int C_QG = 0, C_KG = 512, C_VG = 1024, C_RG = 2048;
constexpr size_t QKV_ELEMS = (size_t)MTOK * 1024;
constexpr float EPS = 1e-6f;
constexpr size_t MiB = 1u << 20;
constexpr size_t WS_WGU1 = 0, WS_WD1 = 44 * MiB, WS_WIN = 66 * MiB, WS_WOUT = 91 * MiB, WS_WGU2 = 99 * MiB, WS_WD2 = 143 * MiB;
constexpr size_t WS_XN = 165 * MiB, WS_HZ = 229 * MiB, WS_ROPE = 429 * MiB, WS_EV = 431 * MiB, WS_GS = 433 * MiB, WS_RS = 497 * MiB, WS_BAR = 498 * MiB, WS_END = 499 * MiB;
constexpr size_t WS_QKVC = 229 * MiB + 96 * MiB;
constexpr size_t WS_OBR = 0, WS_LSE = 64 * MiB, WS_XN2 = 0;
constexpr int LDS_BYTES = 147456;

struct Params {
    const float* x; const float* n1; const float* wg1; const float* wu1; const float* wd1; const float* nmix; const float* win;
    const float* gup; const float* gbias; const float* gonorm; const float* qn; const float* kn; const float* wout;
    const float* n2; const float* wg2; const float* wu2; const float* wd2;
    float* out; unsigned char* ws;
};

__device__ __forceinline__ unsigned cvtpk(float lo, float hi) { f32x2 v = {lo, hi}; bf16x2_t b = __builtin_convertvector(v, bf16x2_t); return __builtin_bit_cast(unsigned, b); }
__device__ __forceinline__ float bf2f(unsigned short h) { return __builtin_bit_cast(float, (unsigned)h << 16); }
__device__ __forceinline__ float bflo(unsigned w) { return __builtin_bit_cast(float, w << 16); }
__device__ __forceinline__ float bfhi(unsigned w) { return __builtin_bit_cast(float, w & 0xffff0000u); }
__device__ __forceinline__ int hw_lane() { int l; asm volatile("v_mbcnt_lo_u32_b32 %0, -1, 0\n\tv_mbcnt_hi_u32_b32 %0, -1, %0" : "=v"(l)); return l; }
__device__ __forceinline__ int ltid(int wave) { return wave * 64 + hw_lane(); }
__device__ __forceinline__ float fexp(float x) { return __builtin_amdgcn_exp2f(x * 1.44269504089f); }
__device__ __forceinline__ float wave_sum(float v) {
#pragma unroll
    for (int o = 1; o < 64; o <<= 1) v += __shfl_xor(v, o);
    return v;
}
__device__ __forceinline__ f32x4 mfma16(bf16x8 a, bf16x8 b, f32x4 c) { return __builtin_amdgcn_mfma_f32_16x16x32_bf16(a, b, c, 0, 0, 0); }
__device__ __forceinline__ s16x4 vtr(const LAS unsigned char* p) { return __builtin_bit_cast(s16x4, __builtin_amdgcn_ds_read_tr16_b64_v4i16((LAS s16x4*)p)); }
__device__ __forceinline__ bf16x8 cat8(s16x4 a, s16x4 b) { bf16x8 r; r[0] = a[0]; r[1] = a[1]; r[2] = a[2]; r[3] = a[3]; r[4] = b[0]; r[5] = b[1]; r[6] = b[2]; r[7] = b[3]; return r; }
__device__ __forceinline__ bf16x8 pack8(f32x4 a, f32x4 b) { u32x4 w; w.x = cvtpk(a[0], a[1]); w.y = cvtpk(a[2], a[3]); w.z = cvtpk(b[0], b[1]); w.w = cvtpk(b[2], b[3]); return __builtin_bit_cast(bf16x8, w); }

#define XB_TMO      128
#define XB_XCNT(j)  (256  + 64 * (j))
#define XB_XSUB(j)  (1280 + 64 * (j))
#define XB_XGEN(j)  (2304 + 64 * (j))
#define XB_TOP      3328
#define XB_TOPGEN   3392
#define XCD_BAR_WORDS 3456
#define XB_SPIN_CAP (1u << 18)

__device__ __forceinline__ unsigned xb_ld(unsigned* p)              { return __hip_atomic_load(p, __ATOMIC_RELAXED, __HIP_MEMORY_SCOPE_AGENT); }
__device__ __forceinline__ unsigned xb_add(unsigned* p, unsigned v) { return __hip_atomic_fetch_add(p, v, __ATOMIC_RELAXED, __HIP_MEMORY_SCOPE_AGENT); }
__device__ __forceinline__ unsigned xb_xcc_id() { return (unsigned)__builtin_amdgcn_s_getreg((3 << 11) | 20) & 0xFu; }
#define XB_SPIN(cond, bar) do { unsigned _sp = 0; while (cond) { __builtin_amdgcn_s_sleep(1); \
    if ((++_sp & 255u) == 0u) { if (xb_ld(&(bar)[XB_TMO])) break; if (_sp > XB_SPIN_CAP) { atomicAdd(&(bar)[XB_TMO], 1u); break; } } } } while (0)

struct XcdBarrier {
    unsigned* bar; unsigned x;
    volatile LAS unsigned* st;
};

__device__ __forceinline__ XcdBarrier xcd_barrier_post(unsigned* bar, volatile LAS unsigned* st, bool leader) {
    XcdBarrier b; b.bar = bar; b.x = xb_xcc_id(); b.st = st;
    if (leader) (void)xb_add(&bar[XB_XCNT(b.x)], 1u);
    return b;
}
__device__ __forceinline__ void xcd_barrier_complete(unsigned* bar, unsigned x, unsigned& nloc, unsigned& nx) {
    const unsigned G = gridDim.x * gridDim.y * gridDim.z;
    unsigned sum, cnt, mine, sp = 0u;
    for (;;) {
        sum = 0u; cnt = 0u; mine = 0u;
#pragma unroll
        for (unsigned j = 0; j < 16; ++j) { const unsigned c = xb_ld(&bar[XB_XCNT(j)]); sum += c; cnt += (c > 0u) ? 1u : 0u; mine = (j == x) ? c : mine; }
        if (sum == G) break;
        __builtin_amdgcn_s_sleep(1);
        if ((++sp & 255u) == 0u) { if (xb_ld(&bar[XB_TMO])) break; if (sp > XB_SPIN_CAP) { atomicAdd(&bar[XB_TMO], 1u); break; } }
    }
    nloc = mine > 0u ? mine : 1u; nx = cnt > 0u ? cnt : 1u;
}

__device__ __forceinline__ void xcd_barrier(const XcdBarrier& b, bool leader) {
    asm volatile("s_waitcnt vmcnt(0)" ::: "memory");
    __syncthreads();
    if (leader) {
        unsigned* bar = b.bar;
        __builtin_amdgcn_s_waitcnt(0);
        unsigned nloc = b.st[0], nx = b.st[1];
        if (nloc == 0u) { xcd_barrier_complete(bar, b.x, nloc, nx); b.st[0] = nloc; b.st[1] = nx; }
        const unsigned old = xb_add(&bar[XB_XSUB(b.x)], 1u);
        const unsigned gen = old / nloc;
        if (old + 1u == (gen + 1u) * nloc) {
            __builtin_amdgcn_fence(__ATOMIC_RELEASE, "agent");
            asm volatile("s_waitcnt vmcnt(0)" ::: "memory");
            const unsigned og = xb_add(&bar[XB_TOP], 1u);
            const unsigned tg = og / nx;
            if (og + 1u == (tg + 1u) * nx) xb_add(&bar[XB_TOPGEN], 1u);
            else XB_SPIN(xb_ld(&bar[XB_TOPGEN]) == tg, bar);
            __builtin_amdgcn_fence(__ATOMIC_ACQUIRE, "agent");
            xb_add(&bar[XB_XGEN(b.x)], 1u);
            asm volatile("s_waitcnt vmcnt(0)" ::: "memory");
        } else {
            XB_SPIN(xb_ld(&bar[XB_XGEN(b.x)]) == gen, bar);
            __builtin_amdgcn_fence(__ATOMIC_ACQUIRE, "agent");
            asm volatile("s_waitcnt vmcnt(0)" ::: "memory");
        }
    }
    __syncthreads();
}

struct TrArgs { const float* W; const float* gk; bf16_t* WT; int ldsrc, k0, srccol0, nvalid, K, dstrow0; };
__device__ __forceinline__ void tr_load(const TrArgs& a, float (&vv)[32], int lane) {
    const int c = lane & 31;
    if (c < a.nvalid) {
        const float* src = a.W + (size_t)(a.k0 + (lane >> 5)) * a.ldsrc + a.srccol0 + c;
#pragma unroll
        for (int i = 0; i < 32; ++i) vv[i] = src[(size_t)(2 * i) * a.ldsrc];
    } else {
#pragma unroll
        for (int i = 0; i < 32; ++i) vv[i] = 0.f;
    }
}
__device__ __forceinline__ void tr_store(const TrArgs& a, const float (&vv)[32], LAS float* scr, int lane) {
    const int c = lane & 31, c8 = lane & 7;
    f32x4 g0 = (f32x4){1.f, 1.f, 1.f, 1.f}, g1 = g0;
    if (a.gk) { g0 = *(const f32x4*)(a.gk + a.k0 + 8 * c8); g1 = *(const f32x4*)(a.gk + a.k0 + 8 * c8 + 4); }
#pragma unroll
    for (int i = 0; i < 32; ++i) scr[(2 * i + (lane >> 5)) * 33 + c] = vv[i];
    asm volatile("s_waitcnt lgkmcnt(0)" ::: "memory");
#pragma unroll
    for (int j = 0; j < 4; ++j) { const int n = (lane >> 3) + 8 * j; const LAS float* s = scr + (8 * c8) * 33 + n;
        u32x4 o; o.x = cvtpk(s[0 * 33] * g0[0], s[1 * 33] * g0[1]); o.y = cvtpk(s[2 * 33] * g0[2], s[3 * 33] * g0[3]);
        o.z = cvtpk(s[4 * 33] * g1[0], s[5 * 33] * g1[1]); o.w = cvtpk(s[6 * 33] * g1[2], s[7 * 33] * g1[3]);
        *(u32x4*)(a.WT + (size_t)(a.dstrow0 + n) * a.K + a.k0 + 8 * c8) = o; }
    asm volatile("s_waitcnt lgkmcnt(0)" ::: "memory");
}
constexpr int TR_I_GU = 32 * 352, TR_I_D = 88 * 64, TR_I_IN = 32 * 200, TR_I_OUT = 32 * 64, TR_NITEMS = 2 * TR_I_GU + 2 * TR_I_D + TR_I_IN + TR_I_OUT;
__device__ __forceinline__ TrArgs tr_decode(const Params& p, int it) {
    TrArgs a; int r = it;
    if (r < 2 * TR_I_GU) { const bool second = r >= TR_I_GU; if (second) r -= TR_I_GU;
        const int kb = r / 352, nb = r % 352, pn = nb >> 3, sub = nb & 7;
        a.W = sub < 4 ? (second ? p.wg2 : p.wg1) : (second ? p.wu2 : p.wu1); a.gk = second ? p.n2 : p.n1; a.WT = (bf16_t*)(p.ws + (second ? WS_WGU2 : WS_WGU1));
        a.ldsrc = FF; a.k0 = 64 * kb; a.srccol0 = 128 * pn + 32 * (sub & 3); a.nvalid = 32; a.K = DM; a.dstrow0 = 32 * nb; return a; }
    r -= 2 * TR_I_GU;
    if (r < 2 * TR_I_D) { const bool second = r >= TR_I_D; if (second) r -= TR_I_D;
        a.W = second ? p.wd2 : p.wd1; a.gk = nullptr; a.WT = (bf16_t*)(p.ws + (second ? WS_WD2 : WS_WD1));
        a.ldsrc = DM; a.k0 = 64 * (r / 64); a.srccol0 = 32 * (r % 64); a.nvalid = 32; a.K = FF; a.dstrow0 = 32 * (r % 64); return a; }
    r -= 2 * TR_I_D;
    if (r < TR_I_IN) { const int kb = r / 200, nb = r % 200, n0 = 32 * nb; int src, nv;
        if (n0 < 2048) { src = n0; nv = 32; } else if (n0 < 6144) { src = n0 + 16; nv = 32; } else if (n0 == 6144) { src = 2048; nv = 16; } else { src = 0; nv = 0; }
        a.W = p.win; a.gk = p.nmix; a.WT = (bf16_t*)(p.ws + WS_WIN); a.ldsrc = DIN_SRC; a.k0 = 64 * kb; a.srccol0 = src; a.nvalid = nv; a.K = DM; a.dstrow0 = n0; return a; }
    r -= TR_I_IN;
    a.W = p.wout; a.gk = nullptr; a.WT = (bf16_t*)(p.ws + WS_WOUT); a.ldsrc = DM; a.k0 = 64 * (r / 64); a.srccol0 = 32 * (r % 64); a.nvalid = 32; a.K = DM; a.dstrow0 = 32 * (r % 64); return a;
}
__device__ __forceinline__ void convert_items(const Params& p, LAS float* scr, int lane, int it0, int it_end, int stride) {
    int it = it0; TrArgs a{}; float vv[32];
    if (it < it_end) { a = tr_decode(p, it); tr_load(a, vv, lane); }
    while (it < it_end) {
        const int nx = it + stride; TrArgs bnx = a; float vn[32];
        if (nx < it_end) { bnx = tr_decode(p, nx); tr_load(bnx, vn, lane); }
        else {
#pragma unroll
            for (int i = 0; i < 32; ++i) vn[i] = 0.f; }
        tr_store(a, vv, scr, lane);
        a = bnx;
#pragma unroll
        for (int i = 0; i < 32; ++i) vv[i] = vn[i];
        it = nx; }
}
__device__ __forceinline__ void rms_row_to_bf16(const float* xrow, bf16_t* orow, int lane) {
    const f32x4* xr = (const f32x4*)xrow + lane;
    f32x4 v[8]; float s = 0.f;
#pragma unroll
    for (int j = 0; j < 8; ++j) { v[j] = xr[64 * j]; s += (v[j].x * v[j].x + v[j].y * v[j].y) + (v[j].z * v[j].z + v[j].w * v[j].w); }
    const float rstd = 1.0f / sqrtf(wave_sum(s) * (1.0f / DM) + EPS);
    u32x2* o8 = (u32x2*)orow + lane;
#pragma unroll
    for (int j = 0; j < 8; ++j) { u32x2 w; w.x = cvtpk(v[j].x * rstd, v[j].y * rstd); w.y = cvtpk(v[j].z * rstd, v[j].w * rstd); o8[64 * j] = w; }
}
__device__ __forceinline__ void norm_pass(const float* src, bf16_t* XN, int gw, int NGW, int lane) {
    lane = hw_lane();
    for (int m = gw; m < MTOK; m += NGW) rms_row_to_bf16(src + (size_t)m * DM, XN + (size_t)m * DM, lane);
}
__device__ __forceinline__ void phase_prologue(const Params& p, LAS unsigned char* lds, int wave, int lane) {
    lane = hw_lane();
    LAS float* scr = (LAS float*)(lds + wave * 16384);
    const int gw = blockIdx.x * 8 + wave, NGW = gridDim.x * 8;
    convert_items(p, scr, lane, gw, (gridDim.x == 256) ? TR_I_GU : TR_NITEMS, NGW);
    f32x2* cs = (f32x2*)(p.ws + WS_ROPE);
    for (int idx = blockIdx.x * 512 + wave * 64 + lane; idx < SEQ * 64; idx += gridDim.x * 512) {
        const int pos = idx >> 6, i = idx & 63;
        double inv = 1.0; for (int k = 0; k < i; ++k) inv *= 0.8659643233600653;
        double a = (double)pos * inv;
        const double kq = __builtin_rint(a * 0.6366197723675814);
        double t = a - kq * 1.5707963267948966; t -= kq * 6.123233995736766e-17;
        const double t2 = t * t;
        double sn = t * (1.0 + t2 * (-1.0 / 6 + t2 * (1.0 / 120 + t2 * (-1.0 / 5040 + t2 * (1.0 / 362880 + t2 * (-1.0 / 39916800 + t2 * (1.0 / 6227020800.0)))))));
        double cn = 1.0 + t2 * (-0.5 + t2 * (1.0 / 24 + t2 * (-1.0 / 720 + t2 * (1.0 / 40320 + t2 * (-1.0 / 3628800 + t2 * (1.0 / 479001600.0 + t2 * (-1.0 / 87178291200.0)))))));
        const int q = ((int)kq) & 3;
        double c = (q == 0) ? cn : (q == 1) ? -sn : (q == 2) ? -cn : sn;
        double s = (q == 0) ? sn : (q == 1) ? cn : (q == 2) ? -sn : -cn;
        cs[idx] = (f32x2){(float)c, (float)s};
    }
    { float* rs = (float*)(p.ws + WS_RS); for (int idx = blockIdx.x * 512 + wave * 64 + lane; idx < 2 * MTOK; idx += gridDim.x * 512) rs[idx] = 0.f; }
    norm_pass(p.x, (bf16_t*)(p.ws + WS_XN), gw, NGW, lane);
}

__device__ __forceinline__ void phase_qkrope_gla_prep(const Params& p, LAS unsigned char* lds, int wave, int lane) {
    bf16_t* Z = (bf16_t*)(p.ws + WS_HZ);
    const int tid = ltid(wave); lane = tid & 63;
    {
        LAS float* part = (LAS float*)lds;
        LAS float* gl = (LAS float*)(lds + 32768);
        float* E1 = (float*)(p.ws + WS_EV); float* E2 = E1 + 256 * 512; float* E3 = E2 + 256 * 512;
        const bf16_t* X1B = (const bf16_t*)p.out; const bf16_t* wgl = (const bf16_t*)(p.ws + WS_WIN) + (size_t)6144 * DM;
        const float* rss1 = (const float*)(p.ws + WS_RS);
        const int fr = lane & 15, g = lane >> 4, d = tid;
        for (int bc = blockIdx.x; bc < 256; bc += gridDim.x) {
            const int m0 = bc * 64;
            __syncthreads();
            f32x4 accg[4];
#pragma unroll
            for (int ti = 0; ti < 4; ++ti) accg[ti] = (f32x4){0.f, 0.f, 0.f, 0.f};
#pragma unroll
            for (int k8 = 0; k8 < 8; ++k8) { const int kk = 256 * wave + 32 * k8 + 8 * g;
                const bf16x8 bfr = *(const bf16x8*)(wgl + (size_t)fr * DM + kk);
#pragma unroll
                for (int ti = 0; ti < 4; ++ti) { const bf16x8 afr = *(const bf16x8*)(X1B + (size_t)(m0 + 16 * ti + fr) * DM + kk);
                    accg[ti] = mfma16(afr, bfr, accg[ti]); } }
#pragma unroll
            for (int ti = 0; ti < 4; ++ti)
#pragma unroll
                for (int jj = 0; jj < 4; ++jj) part[(wave * 64 + 16 * ti + 4 * g + jj) * 16 + fr] = accg[ti][jj];
            __syncthreads();
#pragma unroll
            for (int i = 0; i < 2; ++i) { const int idx = tid + 512 * i, tok = idx >> 4; float sum = 0.f;
#pragma unroll
                for (int w = 0; w < 8; ++w) sum += part[w * 1024 + idx];
                gl[idx] = sum / sqrtf(rss1[m0 + tok] * (1.0f / DM) + EPS); }
            float gu[16];
#pragma unroll
            for (int r = 0; r < 16; ++r) gu[r] = p.gup[r * 512 + d];
            const float bias = p.gbias[d];
            __syncthreads();
            float bl[64]; float run = 0.f;
#pragma unroll
            for (int t = 0; t < 64; ++t) { float lg = bias;
#pragma unroll
                for (int r = 0; r < 16; ++r) lg += gl[t * 16 + r] * gu[r];
                const float ls = fminf(lg, 0.f) - 0.69314718056f * __builtin_amdgcn_logf(1.0f + fexp(-fabsf(lg)));
                run += ls * (1.0f / 16.0f); bl[t] = run; }
            const float bref = bl[31], blast = bl[63];
#pragma unroll
            for (int tb = 0; tb < 4; ++tb) {
                unsigned short qv[16], kv[16];
#pragma unroll
                for (int t = 0; t < 16; ++t) { const size_t ro = (size_t)(m0 + 16 * tb + t) * ZP + d; qv[t] = Z[ro + C_QG]; kv[t] = Z[ro + C_KG]; }
#pragma unroll
                for (int t = 0; t < 16; ++t) { const size_t ro = (size_t)(m0 + 16 * tb + t) * ZP + d; const float bb = bl[16 * tb + t];
                    const float qs = bf2f(qv[t]) * 0.08838834764831845f * fexp(bb - bref), ks = bf2f(kv[t]) * fexp(bref - bb);
                    Z[ro + C_QG] = (bf16_t)(cvtpk(qs, 0.f) & 0xffffu); Z[ro + C_KG] = (bf16_t)(cvtpk(ks, 0.f) & 0xffffu); }
            }
            { const size_t eo = (size_t)bc * 512 + d; E1[eo] = fexp(bref); E2[eo] = fexp(blast - bref); E3[eo] = fexp(blast); }
        }
        __syncthreads();
    }
    {
        const f32x2* cs = (const f32x2*)(p.ws + WS_ROPE);
        const int gw = blockIdx.x * 8 + wave, NGW = gridDim.x * 8;
        const int isk = lane >> 5, i = lane & 31;
        const float* gn = isk ? p.kn : p.qn;
        const float g1a = gn[2 * i], g1b = gn[2 * i + 1], g2a = gn[64 + 2 * i], g2b = gn[64 + 2 * i + 1];
        const float osc = isk ? 1.0f : 0.12751743082459868f;
        for (int m = gw; m < MTOK; m += NGW) {
            const int pos = m & (SEQ - 1);
            bf16_t* row0 = (bf16_t*)(p.ws + WS_QKVC) + (isk ? QKV_ELEMS : 0) + ((size_t)(m >> 12) * 8 * SEQ + pos) * 128;
            unsigned w1[8], w2[8];
#pragma unroll
            for (int h = 0; h < 8; ++h) { w1[h] = *(const unsigned*)(row0 + (size_t)h * SEQ * 128 + 2 * i); w2[h] = *(const unsigned*)(row0 + (size_t)h * SEQ * 128 + 64 + 2 * i); }
            const f32x4 c4 = *(const f32x4*)(cs + pos * 64 + 2 * i);
            unsigned o1[8], o2[8];
#pragma unroll
            for (int h = 0; h < 8; ++h) {
                const float x1a = bflo(w1[h]), x1b = bfhi(w1[h]), x2a = bflo(w2[h]), x2b = bfhi(w2[h]);
                float ss = (x1a * x1a + x1b * x1b) + (x2a * x2a + x2b * x2b);
#pragma unroll
                for (int o = 1; o < 32; o <<= 1) ss += __shfl_xor(ss, o);
                const float rstd = osc / sqrtf(ss * (1.0f / 128.0f) + EPS);
                const float y1a = x1a * rstd * g1a, y1b = x1b * rstd * g1b, y2a = x2a * rstd * g2a, y2b = x2b * rstd * g2b;
                const float o1a = y1a * c4.x - y2a * c4.y, o2a = y2a * c4.x + y1a * c4.y;
                const float o1b = y1b * c4.z - y2b * c4.w, o2b = y2b * c4.z + y1b * c4.w;
                o1[h] = cvtpk(o1a, o1b); o2[h] = cvtpk(o2a, o2b); }
#pragma unroll
            for (int h = 0; h < 8; ++h) { *(unsigned*)(row0 + (size_t)h * SEQ * 128 + 2 * i) = o1[h]; *(unsigned*)(row0 + (size_t)h * SEQ * 128 + 64 + 2 * i) = o2[h]; }
        }
    }
}

constexpr int G_QL = 0, G_KL = 17408, G_VL = 34816, G_PL = 68608, G_EL = 77824, G_SS = 79360, G_OL = 81408;
template <bool WITH_Q>
__device__ __forceinline__ void gla_stage(const bf16_t* Z, LAS unsigned char* lds, size_t m0, int h, int tid) {
    u32x4 pq[2], pk[2], pv[4];
#pragma unroll
    for (int i = 0; i < 2; ++i) { const int ci = tid + 512 * i, row = ci >> 4, cc = ci & 15;
        if (WITH_Q) pq[i] = *(const u32x4*)(Z + (m0 + row) * ZP + C_QG + h * 128 + 8 * cc);
        pk[i] = *(const u32x4*)(Z + (m0 + row) * ZP + C_KG + h * 128 + 8 * cc); }
#pragma unroll
    for (int i = 0; i < 4; ++i) { const int ci = tid + 512 * i, row = ci >> 5, cc = ci & 31;
        pv[i] = *(const u32x4*)(Z + (m0 + row) * ZP + C_VG + h * 256 + 8 * cc); }
#pragma unroll
    for (int i = 0; i < 2; ++i) { const int ci = tid + 512 * i, row = ci >> 4, cc = ci & 15;
        if (WITH_Q) *(LAS u32x4*)(lds + G_QL + row * 272 + cc * 16) = pq[i];
        *(LAS u32x4*)(lds + G_KL + row * 272 + cc * 16) = pk[i]; }
#pragma unroll
    for (int i = 0; i < 4; ++i) { const int ci = tid + 512 * i, row = ci >> 5, cc = ci & 31;
        *(LAS u32x4*)(lds + G_VL + row * 528 + cc * 16) = pv[i]; }
}
__device__ __forceinline__ void gla_passA(const Params& p, LAS unsigned char* lds, int item, int wave, int lane) {
    const bf16_t* Z = (const bf16_t*)(p.ws + WS_HZ);
    const float* EV = (const float*)(p.ws + WS_EV);
    bf16_t* GS = (bf16_t*)(p.ws + WS_GS);
    const int tid = ltid(wave); lane = tid & 63;
    const int c = item & 63, bh = item >> 6, b = bh >> 2, h = bh & 3, fr = lane & 15, g = lane >> 4;
    const size_t m0 = (size_t)b * SEQ + 64 * c;
    __syncthreads();
    gla_stage<false>(Z, lds, m0, h, tid);
    if (tid < 32) *(LAS f32x4*)(lds + G_EL + 512 + tid * 16) = *(const f32x4*)(EV + (size_t)256 * 512 + (size_t)(b * 64 + c) * 512 + h * 128 + 4 * tid);
    __syncthreads();
    bf16x8 vB[2][2];
#pragma unroll
    for (int ks = 0; ks < 2; ++ks)
#pragma unroll
        for (int dvi = 0; dvi < 2; ++dvi) { const LAS unsigned char* ap = lds + G_VL + (32 * ks + 8 * g + (fr >> 2)) * 528 + (32 * wave + 16 * dvi + 4 * (fr & 3)) * 2;
            vB[ks][dvi] = cat8(vtr(ap), vtr(ap + 4 * 528)); }
#pragma unroll
    for (int k4 = 0; k4 < 4; ++k4) {
        f32x4 u[2][2];
#pragma unroll
        for (int t = 0; t < 2; ++t) { const int dkt = 2 * k4 + t;
            f32x4 u0 = (f32x4){0.f, 0.f, 0.f, 0.f}, u1 = (f32x4){0.f, 0.f, 0.f, 0.f};
#pragma unroll
            for (int ks = 0; ks < 2; ++ks) { const LAS unsigned char* ap = lds + G_KL + (32 * ks + 8 * g + (fr >> 2)) * 272 + (16 * dkt + 4 * (fr & 3)) * 2;
                const bf16x8 a = cat8(vtr(ap), vtr(ap + 4 * 272));
                u0 = mfma16(a, vB[ks][0], u0); u1 = mfma16(a, vB[ks][1], u1); }
            const f32x4 e2 = *(const LAS f32x4*)(lds + G_EL + 512 + (16 * dkt + 4 * g) * 4);
            u[t][0] = u0 * e2; u[t][1] = u1 * e2; }
        bf16_t* dst = GS + (((size_t)item * 8 + wave) * 8 + k4 * 2) * 512 + lane * 8;
        *(bf16x8*)dst = pack8(u[0][0], u[1][0]);
        *(bf16x8*)(dst + 512) = pack8(u[0][1], u[1][1]);
    }
}
__device__ __forceinline__ void gla_scan(const Params& p, LAS unsigned char* lds, int wave) {
    const float* EV = (const float*)(p.ws + WS_EV);
    const int tid = ltid(wave);
    for (int T0 = blockIdx.x * 512; T0 < 16 * 8192; T0 += gridDim.x * 512) {
        const int bh = T0 >> 13, b = bh >> 2, h = bh & 3;
        __syncthreads();
#pragma unroll
        for (int i = 0; i < 4; ++i) { const int idx = tid + 512 * i, c = idx >> 5, j = idx & 31;
            const float* src = EV + (size_t)(b * 64 + c) * 512 + h * 128 + 4 * j;
            *(LAS f32x4*)(lds + (c * 128 + 4 * j) * 4) = *(const f32x4*)src;
            *(LAS f32x4*)(lds + 32768 + (c * 128 + 4 * j) * 4) = *(const f32x4*)(src + (size_t)2 * 256 * 512); }
        __syncthreads();
        const int T = T0 + tid, piece = T & 8191, ks = (piece >> 8) & 3, ln = (piece >> 1) & 63, half = piece & 1, g = ln >> 4;
        const int dk = 32 * ks + 16 * half + 4 * g;
        u32x2* base = (u32x2*)(p.ws + WS_GS) + (size_t)(bh * 64) * 8192 + piece;
        f32x4 s = (f32x4){0.f, 0.f, 0.f, 0.f};
        u32x2 ucur = base[0]; base[0] = (u32x2){0u, 0u};
#pragma unroll 1
        for (int cb = 0; cb < 4; ++cb) {
            u32x2 uu[16];
#pragma unroll
            for (int i = 0; i < 16; ++i) { const int cn = 16 * cb + i + 1; const int cl = cn < 64 ? cn : 63; uu[i] = base[(size_t)cl * 8192]; }
#pragma unroll
            for (int i = 0; i < 16; ++i) { const int cn = 16 * cb + i + 1;
                if (cn < 64) {
                    const f32x4 e3 = *(const LAS f32x4*)(lds + 32768 + ((cn - 1) * 128 + dk) * 4), e1 = *(const LAS f32x4*)(lds + (cn * 128 + dk) * 4);
                    const f32x4 uf = (f32x4){bflo(ucur.x), bfhi(ucur.x), bflo(ucur.y), bfhi(ucur.y)};
                    s = e3 * s + uf;
                    const f32x4 o = e1 * s; u32x2 w; w.x = cvtpk(o[0], o[1]); w.y = cvtpk(o[2], o[3]);
                    base[(size_t)cn * 8192] = w; ucur = uu[i]; } }
        }
    }
    __syncthreads();
}
__device__ __forceinline__ void gla_passC(const Params& p, LAS unsigned char* lds, int item, int wave, int lane) {
    const bf16_t* Z = (const bf16_t*)(p.ws + WS_HZ);
    bf16_t* OA = (bf16_t*)(p.ws + WS_XN);
    const bf16_t* GS = (const bf16_t*)(p.ws + WS_GS);
    const int tid = ltid(wave); lane = tid & 63;
    const int c = item & 63, bh = item >> 6, b = bh >> 2, h = bh & 3, fr = lane & 15, g = lane >> 4;
    const size_t m0 = (size_t)b * SEQ + 64 * c;
    const float gn0 = p.gonorm[32 * wave + fr], gn1 = p.gonorm[32 * wave + 16 + fr];
    LAS unsigned char* L = lds;
    __syncthreads();
    gla_stage<true>(Z, lds, m0, h, tid);
    __syncthreads();
    bf16x8 sbf[4][2];
#pragma unroll
    for (int ks = 0; ks < 4; ++ks) { const bf16_t* src = GS + (((size_t)item * 8 + wave) * 8 + ks * 2) * 512 + lane * 8;
        sbf[ks][0] = *(const bf16x8*)src; sbf[ks][1] = *(const bf16x8*)(src + 512); }
    u32x4 prg[4];
#pragma unroll
    for (int i = 0; i < 4; ++i) { const int ci = tid + 512 * i, row = ci >> 5, cc = ci & 31;
        prg[i] = *(const u32x4*)(Z + (m0 + row) * ZP + C_RG + h * 256 + 8 * cc); }
        {
            const int ti = wave >> 1;
#pragma unroll
            for (int jx = 0; jx < 2; ++jx) { const int tj = 2 * (wave & 1) + jx;
                f32x4 acc = (f32x4){0.f, 0.f, 0.f, 0.f};
                if (tj <= ti) {
#pragma unroll
                    for (int ks = 0; ks < 4; ++ks) {
                        const bf16x8 a = *(const LAS bf16x8*)(L + G_QL + (16 * ti + fr) * 272 + (32 * ks + 8 * g) * 2);
                        const bf16x8 bb = *(const LAS bf16x8*)(L + G_KL + (16 * tj + fr) * 272 + (32 * ks + 8 * g) * 2);
                        acc = mfma16(a, bb, acc); }
                }
#pragma unroll
                for (int jj = 0; jj < 4; ++jj) { float v = acc[jj];
                    if (tj > ti || (tj == ti && fr > 4 * g + jj)) v = 0.f;
                    *(LAS unsigned short*)(L + G_PL + (16 * ti + 4 * g + jj) * 144 + (16 * tj + fr) * 2) = (unsigned short)(cvtpk(v, 0.f) & 0xffffu); }
            }
        }
        __syncthreads();
        f32x4 oacc[4][2];
#pragma unroll
        for (int ti = 0; ti < 4; ++ti) { oacc[ti][0] = (f32x4){0.f, 0.f, 0.f, 0.f}; oacc[ti][1] = (f32x4){0.f, 0.f, 0.f, 0.f}; }
        bf16x8 vB[2][2];
#pragma unroll
        for (int ks = 0; ks < 2; ++ks)
#pragma unroll
            for (int dvi = 0; dvi < 2; ++dvi) { const LAS unsigned char* ap = L + G_VL + (32 * ks + 8 * g + (fr >> 2)) * 528 + (32 * wave + 16 * dvi + 4 * (fr & 3)) * 2;
                vB[ks][dvi] = cat8(vtr(ap), vtr(ap + 4 * 528)); }
#pragma unroll
        for (int ti = 0; ti < 4; ++ti)
#pragma unroll
            for (int ks = 0; ks < 2; ++ks) { if (32 * ks > 16 * ti + 15) continue;
                const bf16x8 a = *(const LAS bf16x8*)(L + G_PL + (16 * ti + fr) * 144 + (32 * ks + 8 * g) * 2);
                oacc[ti][0] = mfma16(a, vB[ks][0], oacc[ti][0]); oacc[ti][1] = mfma16(a, vB[ks][1], oacc[ti][1]); }
        __builtin_amdgcn_sched_barrier(0);
#pragma unroll
        for (int ks = 0; ks < 4; ++ks) {
#pragma unroll
            for (int ti = 0; ti < 4; ++ti) {
                const s16x4 qa = *(const LAS s16x4*)(L + G_QL + (16 * ti + fr) * 272 + (32 * ks + 4 * g) * 2);
                const s16x4 qb = *(const LAS s16x4*)(L + G_QL + (16 * ti + fr) * 272 + (32 * ks + 16 + 4 * g) * 2);
                const bf16x8 a = cat8(qa, qb);
                oacc[ti][0] = mfma16(a, sbf[ks][0], oacc[ti][0]); oacc[ti][1] = mfma16(a, sbf[ks][1], oacc[ti][1]); }
        }
        __builtin_amdgcn_sched_barrier(0);
#pragma unroll
        for (int ti = 0; ti < 4; ++ti)
#pragma unroll
            for (int jj = 0; jj < 4; ++jj) { float s = oacc[ti][0][jj] * oacc[ti][0][jj] + oacc[ti][1][jj] * oacc[ti][1][jj];
                s += __shfl_xor(s, 1); s += __shfl_xor(s, 2); s += __shfl_xor(s, 4); s += __shfl_xor(s, 8);
                if (fr == 0) *(LAS float*)(L + G_SS + ((16 * ti + 4 * g + jj) * 8 + wave) * 4) = s; }
        __syncthreads();
#pragma unroll
        for (int ti = 0; ti < 4; ++ti)
#pragma unroll
            for (int jj = 0; jj < 4; ++jj) { const int tok = 16 * ti + 4 * g + jj;
                const f32x4 sa = *(const LAS f32x4*)(L + G_SS + tok * 32), sb = *(const LAS f32x4*)(L + G_SS + tok * 32 + 16);
                const float tot = ((sa.x + sa.y) + (sa.z + sa.w)) + ((sb.x + sb.y) + (sb.z + sb.w));
                const float rstd = 1.0f / sqrtf(tot * (1.0f / 256.0f) + EPS);
                *(LAS unsigned short*)(L + G_OL + tok * 528 + (32 * wave + fr) * 2) = (unsigned short)(cvtpk(oacc[ti][0][jj] * rstd * gn0, 0.f) & 0xffffu);
                *(LAS unsigned short*)(L + G_OL + tok * 528 + (32 * wave + 16 + fr) * 2) = (unsigned short)(cvtpk(oacc[ti][1][jj] * rstd * gn1, 0.f) & 0xffffu); }
        __syncthreads();
#pragma unroll
        for (int i = 0; i < 4; ++i) { const int ci = tid + 512 * i, row = ci >> 5, cc = ci & 31;
            const u32x4 ov = *(const LAS u32x4*)(L + G_OL + row * 528 + cc * 16); const u32x4 rv = prg[i]; u32x4 w;
#pragma unroll
            for (int e = 0; e < 4; ++e) { const float r0 = bflo(rv[e]), r1 = bfhi(rv[e]);
                const float s0 = r0 * __builtin_amdgcn_rcpf(1.0f + fexp(-r0)), s1 = r1 * __builtin_amdgcn_rcpf(1.0f + fexp(-r1));
                w[e] = cvtpk(bflo(ov[e]) * s0, bfhi(ov[e]) * s1); }
            *(u32x4*)(OA + (m0 + row) * DM + h * 256 + 8 * cc) = w; }
}

__device__ __forceinline__ void attn_units(const Params& p, LAS unsigned char* buf, int sel, int wave) {
    const bf16_t* QKVC = (const bf16_t*)(p.ws + WS_QKVC);
    bf16_t* OBR = (bf16_t*)(p.ws + WS_OBR); float* LSE = (float*)(p.ws + WS_LSE);
    bf16_t* OA = (bf16_t*)(p.ws + WS_XN);
    int lane = hw_lane(), tid = wave * 64 + lane, fr = lane & 15, g = lane >> 4;
    const int G = gridDim.x, total = sel == 0 ? 1024 : 512;
    const int nk = ((int)blockIdx.x < total) ? (total - (int)blockIdx.x + G - 1) / G : 0;
    if (nk == 0) return;
    int ub, uh, ur, urho, un, uslot;
#define AU_DECODE(U_) do { int U = (U_); int bh; if (sel == 0) { if (U < 512) { bh = U >> 4; un = U & 15; ur = 1; urho = 0; uslot = 0; } \
            else { U -= 512; bh = U >> 4; urho = (U >> 2) & 3; un = U & 3; ur = 4; uslot = 1; } } \
        else { bh = U >> 4; urho = U & 15; un = 0; ur = 16; uslot = 0; } ub = bh >> 3; uh = bh & 7; } while (0)
#define AU_KVLOAD(which) do { _Pragma("unroll") for (int i = 0; i < 12; ++i) { const int pc = tid + 512 * i, row = pc >> 4, cc = pc & 15; int j = 256 * un - 128 + row; j = j < 0 ? 0 : j; \
        kvreg[i] = *(const u32x4*)(QKVC + (size_t)(which) * QKV_ELEMS + ((size_t)(ub * 8 + uh) * SEQ + (size_t)j * ur + urho) * 128 + 8 * cc); } } while (0)
#define AU_QLOAD() do { _Pragma("unroll") for (int qt = 0; qt < 2; ++qt) { const bf16_t* qp = QKVC + ((size_t)(ub * 8 + uh) * SEQ + (size_t)(256 * un + 32 * wave + 16 * qt + fr) * ur + urho) * 128 + 8 * g; \
        _Pragma("unroll") for (int ks = 0; ks < 4; ++ks) qf[qt][ks] = *(const bf16x8*)(qp + 32 * ks); } } while (0)
    u32x4 kvreg[12]; bf16x8 qf[2][4];
    AU_DECODE((int)blockIdx.x);
    AU_KVLOAD(1);
#pragma unroll 1
    for (int k = 0; k < nk; ++k) {
        lane = hw_lane(); tid = wave * 64 + lane; fr = lane & 15; g = lane >> 4;
        const int b = ub, h = uh, r = ur, rho = urho, n = un, slot = uslot;
        const size_t rb = (size_t)b * SEQ; const int i0 = 256 * n + 32 * wave;
        __syncthreads();
        AU_QLOAD();
#pragma unroll
        for (int i = 0; i < 12; ++i) { const int pc = tid + 512 * i, row = pc >> 4, cc = pc & 15; *(LAS u32x4*)(buf + row * 272 + cc * 16) = kvreg[i]; }
        __syncthreads();
        f32x4 sc[10][2];
#pragma unroll
        for (int kt = 0; kt < 10; ++kt) {
            bf16x8 kfr[4];
#pragma unroll
            for (int ks = 0; ks < 4; ++ks) kfr[ks] = *(const LAS bf16x8*)(buf + (32 * wave + 16 * kt + fr) * 272 + (32 * ks + 8 * g) * 2);
#pragma unroll
            for (int qt = 0; qt < 2; ++qt) { f32x4 a = (f32x4){0.f, 0.f, 0.f, 0.f};
#pragma unroll
                for (int ks = 0; ks < 4; ++ks) a = mfma16(kfr[ks], qf[qt][ks], a);
                sc[kt][qt] = a; } }
        __builtin_amdgcn_sched_barrier(0);
        AU_KVLOAD(2);
        __builtin_amdgcn_sched_barrier(0);
        float mq[2], lq[2];
#pragma unroll
        for (int qt = 0; qt < 2; ++qt) { float mx = -INFINITY;
#pragma unroll
            for (int kt = 0; kt < 10; ++kt)
#pragma unroll
                for (int jj = 0; jj < 4; ++jj) { const int dist = 128 + 16 * (qt - kt) + fr - 4 * g - jj, jk = i0 - 128 + 16 * kt + 4 * g + jj;
                    const bool ok = (dist >= 0) && (dist <= 128) && (jk >= 0);
                    const float v = ok ? sc[kt][qt][jj] : -INFINITY; sc[kt][qt][jj] = v; mx = fmaxf(mx, v); }
            mx = fmaxf(mx, __shfl_xor(mx, 16)); mx = fmaxf(mx, __shfl_xor(mx, 32));
            float l = 0.f;
#pragma unroll
            for (int kt = 0; kt < 10; ++kt)
#pragma unroll
                for (int jj = 0; jj < 4; ++jj) { const float e = __builtin_amdgcn_exp2f(sc[kt][qt][jj] - mx); sc[kt][qt][jj] = e; l += e; }
            l += __shfl_xor(l, 16); l += __shfl_xor(l, 32);
            mq[qt] = mx; lq[qt] = l; }
        bf16x8 pf[5][2];
#pragma unroll
        for (int kk = 0; kk < 5; ++kk) { pf[kk][0] = pack8(sc[2 * kk][0], sc[2 * kk + 1][0]); pf[kk][1] = pack8(sc[2 * kk][1], sc[2 * kk + 1][1]); }
        __syncthreads();
#pragma unroll
        for (int i = 0; i < 12; ++i) { const int pc = tid + 512 * i, row = pc >> 4, cc = pc & 15; *(LAS u32x4*)(buf + row * 288 + cc * 16) = kvreg[i]; }
        __syncthreads();
        if (k + 1 < nk) { AU_DECODE((int)blockIdx.x + G * (k + 1)); AU_KVLOAD(1); }
        f32x4 oacc[8][2];
#pragma unroll
        for (int d = 0; d < 8; ++d) { oacc[d][0] = (f32x4){0.f, 0.f, 0.f, 0.f}; oacc[d][1] = (f32x4){0.f, 0.f, 0.f, 0.f}; }
#pragma unroll
        for (int kk = 0; kk < 5; ++kk) {
#pragma unroll
            for (int d = 0; d < 8; ++d) { const LAS unsigned char* ap = buf + (32 * wave + 32 * kk + 4 * g + (fr >> 2)) * 288 + (16 * d + 4 * (fr & 3)) * 2;
                const bf16x8 vf = cat8(vtr(ap), vtr(ap + 16 * 288));
                oacc[d][0] = mfma16(vf, pf[kk][0], oacc[d][0]); oacc[d][1] = mfma16(vf, pf[kk][1], oacc[d][1]); }
        }
#pragma unroll
        for (int qt = 0; qt < 2; ++qt) {
            const size_t m = rb + (size_t)(i0 + 16 * qt + fr) * r + rho;
            const float inv = 1.0f / lq[qt], lse = mq[qt] + log2f(lq[qt]);
            if (sel == 0) {
                if (g == 0) LSE[(size_t)slot * MTOK * 8 + m * 8 + h] = lse;
#pragma unroll
                for (int d = 0; d < 8; ++d) { const f32x4 o = oacc[d][qt] * inv; u32x2 w; w.x = cvtpk(o[0], o[1]); w.y = cvtpk(o[2], o[3]);
                    *(u32x2*)(OBR + (size_t)slot * MTOK * 1024 + m * 1024 + h * 128 + 16 * d + 4 * g) = w; }
            } else {
                const float l0 = LSE[m * 8 + h], l1 = LSE[(size_t)MTOK * 8 + m * 8 + h];
                const float M = fmaxf(fmaxf(l0, l1), lse);
                const float w0 = __builtin_amdgcn_exp2f(l0 - M), w1 = __builtin_amdgcn_exp2f(l1 - M), w2 = __builtin_amdgcn_exp2f(lse - M);
                const float wi = 1.0f / (w0 + w1 + w2), a0 = w0 * wi, a1 = w1 * wi, a2 = w2 * wi * inv;
#pragma unroll
                for (int d = 0; d < 8; ++d) { const size_t off = m * 1024 + h * 128 + 16 * d + 4 * g;
                    const u32x2 x0 = *(const u32x2*)(OBR + off), x1 = *(const u32x2*)(OBR + (size_t)MTOK * 1024 + off);
                    const f32x4 o = oacc[d][qt];
                    const float r0 = a0 * bflo(x0.x) + a1 * bflo(x1.x) + a2 * o[0], r1 = a0 * bfhi(x0.x) + a1 * bfhi(x1.x) + a2 * o[1];
                    const float r2 = a0 * bflo(x0.y) + a1 * bflo(x1.y) + a2 * o[2], r3 = a0 * bfhi(x0.y) + a1 * bfhi(x1.y) + a2 * o[3];
                    u32x2 w; w.x = cvtpk(r0, r1); w.y = cvtpk(r2, r3);
                    *(u32x2*)(OA + m * DM + 1024 + h * 128 + 16 * d + 4 * g) = w; }
            }
        }
    }
    __syncthreads();
#undef AU_DECODE
#undef AU_KVLOAD
#undef AU_QLOAD
}

__global__ void __launch_bounds__(512) fwd_kernel(Params p) {
    extern __shared__ __attribute__((aligned(16))) unsigned char lds_raw[];
    LAS unsigned char* lds = (LAS unsigned char*)lds_raw;
    cg::grid_group grid = cg::this_grid();
    const int tid = threadIdx.x, lane = tid & 63, wave = __builtin_amdgcn_readfirstlane(tid >> 6);
    const int gw = blockIdx.x * 8 + wave, NGW = gridDim.x * 8, G = gridDim.x;
    bf16_t* wgu1 = (bf16_t*)(p.ws + WS_WGU1); bf16_t* wd1 = (bf16_t*)(p.ws + WS_WD1); bf16_t* win = (bf16_t*)(p.ws + WS_WIN); bf16_t* wout = (bf16_t*)(p.ws + WS_WOUT);
    bf16_t* wgu2 = (bf16_t*)(p.ws + WS_WGU2); bf16_t* wd2 = (bf16_t*)(p.ws + WS_WD2);
    bf16_t* XN = (bf16_t*)(p.ws + WS_XN); bf16_t* HZ = (bf16_t*)(p.ws + WS_HZ);

    const bool leader = (wave == 0) && (hw_lane() == 0);
    volatile LAS unsigned* bst = (volatile LAS unsigned*)(lds + LDS_BYTES - 16);
    if (leader) { bst[0] = 0u; bst[1] = 0u; }
    __syncthreads();
    const XcdBarrier xbar = xcd_barrier_post((unsigned*)(p.ws + WS_BAR), bst, leader);
    if (p.ws == nullptr) grid.sync();
    phase_prologue(p, lds, wave, lane);
    xcd_barrier(xbar, leader);
    float* rss1 = (float*)(p.ws + WS_RS); float* rss2 = rss1 + MTOK;
    { pg8::Gemm g{XN, wgu1, MTOK, 2 * FF, DM}; pg8::StaticOrder S; S.init(MTOK, 2 * FF, G, (int)blockIdx.x); pg8::EpiSwiGLU E{HZ, FF, nullptr};
      const bool stag = (G == 256), early = (((int)blockIdx.x >> 3) & 1) == 0;
      if (stag && early) { convert_items(p, (LAS float*)(lds + wave * 16384), hw_lane(), TR_I_GU + gw, TR_NITEMS, NGW); __syncthreads(); }
      pg8::gemm_phase<pg8::EpiSwiGLU, pg8::StaticOrder, true, true>(lds, g, S, E, wave);
      if (stag && !early) { __syncthreads(); convert_items(p, (LAS float*)(lds + wave * 16384), hw_lane(), TR_I_GU + gw, TR_NITEMS, NGW); } }
    xcd_barrier(xbar, leader);
    bf16_t* X1B = (bf16_t*)p.out;
    { pg8::Gemm g{HZ, wd1, MTOK, DM, FF}; pg8::StaticOrder S; S.init(MTOK, DM, G, (int)blockIdx.x); pg8::EpiResidNorm<false> E{p.x, X1B, rss1, DM, 0.5f};
      pg8::gemm_phase<pg8::EpiResidNorm<false>, pg8::StaticOrder, true, true>(lds, g, S, E, wave); }
    xcd_barrier(xbar, leader);
    { pg8::Gemm g{X1B, win, MTOK, 6144, DM}; pg8::StaticOrder S; S.init(MTOK, 6144, G, (int)blockIdx.x); pg8::EpiBf16 E{HZ, ZP, rss1, (bf16_t*)(p.ws + WS_QKVC)};
      pg8::gemm_phase<pg8::EpiBf16, pg8::StaticOrder, true, true>(lds, g, S, E, wave); }
    xcd_barrier(xbar, leader);
    phase_qkrope_gla_prep(p, lds, wave, lane);
    xcd_barrier(xbar, leader);
    for (int it = (int)blockIdx.x; it < 1024; it += G) gla_passA(p, lds, it, wave, lane);
    __syncthreads();
    attn_units(p, lds, 0, wave);
    xcd_barrier(xbar, leader);
    gla_scan(p, lds, wave);
    xcd_barrier(xbar, leader);
    for (int it = (int)blockIdx.x; it < 1024; it += G) gla_passC(p, lds, it, wave, lane);
    __syncthreads();
    attn_units(p, lds, 1, wave);
    xcd_barrier(xbar, leader);
    { pg8::Gemm g{XN, wout, MTOK, DM, DM}; pg8::StaticOrder S; S.init(MTOK, DM, G, (int)blockIdx.x); pg8::EpiResidNorm<true> E{X1B, (bf16_t*)(p.ws + WS_XN2), rss2, DM, 1.0f};
      pg8::gemm_phase<pg8::EpiResidNorm<true>, pg8::StaticOrder, true, true>(lds, g, S, E, wave); }
    xcd_barrier(xbar, leader);
    { pg8::Gemm g{(bf16_t*)(p.ws + WS_XN2), wgu2, MTOK, 2 * FF, DM}; pg8::StaticOrder S; S.init(MTOK, 2 * FF, G, (int)blockIdx.x); pg8::EpiSwiGLU E{HZ, FF, rss2};
      pg8::gemm_phase<pg8::EpiSwiGLU, pg8::StaticOrder, true, true>(lds, g, S, E, wave); }
    xcd_barrier(xbar, leader);
    { pg8::Gemm g{HZ, wd2, MTOK, DM, FF}; pg8::StaticOrder S; S.init(MTOK, DM, G, (int)blockIdx.x); pg8::EpiResid E{(const bf16_t*)(p.ws + WS_XN2), p.out, DM, 0.5f};
      pg8::gemm_phase<pg8::EpiResid, pg8::StaticOrder, true, true>(lds, g, S, E, wave); }
}

extern "C" void kernel_launch(void* const* d_in, const int* in_sizes, int n_in, void* d_out, int out_size, void* d_ws, size_t ws_size, hipStream_t stream) {
    static int grid = 0;
    if (grid == 0) {
        if (n_in != 17 || out_size != MTOK * DM || ws_size < WS_END) { fprintf(stderr, "kernel_launch: unexpected shapes (n_in %d out %d ws %zu)\n", n_in, out_size, ws_size); grid = -1; return; }
        int dev = 0, cus = 0, per_cu = 0;
        (void)hipGetDevice(&dev); (void)hipDeviceGetAttribute(&cus, hipDeviceAttributeMultiprocessorCount, dev);
        if (hipFuncSetAttribute((const void*)fwd_kernel, hipFuncAttributeMaxDynamicSharedMemorySize, LDS_BYTES) != hipSuccess) { fprintf(stderr, "kernel_launch: hipFuncSetAttribute failed\n"); grid = -1; return; }
        if (hipOccupancyMaxActiveBlocksPerMultiprocessor(&per_cu, (const void*)fwd_kernel, 512, LDS_BYTES) != hipSuccess || per_cu < 1) { fprintf(stderr, "kernel_launch: occupancy query gave %d\n", per_cu); per_cu = 1; (void)hipGetLastError(); }
        grid = cus * per_cu;
    }
    if (grid < 0) return;
    Params p{};
    p.x = (const float*)d_in[0]; p.n1 = (const float*)d_in[1]; p.wg1 = (const float*)d_in[2]; p.wu1 = (const float*)d_in[3]; p.wd1 = (const float*)d_in[4];
    p.nmix = (const float*)d_in[5]; p.win = (const float*)d_in[6]; p.gup = (const float*)d_in[7]; p.gbias = (const float*)d_in[8]; p.gonorm = (const float*)d_in[9];
    p.qn = (const float*)d_in[10]; p.kn = (const float*)d_in[11]; p.wout = (const float*)d_in[12]; p.n2 = (const float*)d_in[13];
    p.wg2 = (const float*)d_in[14]; p.wu2 = (const float*)d_in[15]; p.wd2 = (const float*)d_in[16];
    p.out = (float*)d_out; p.ws = (unsigned char*)d_ws;
    (void)hipMemsetAsync((char*)d_ws + WS_BAR, 0, 16384, stream);
    void* args[] = {&p};
    hipError_t e = hipLaunchCooperativeKernel((const void*)fwd_kernel, dim3(grid), dim3(512), args, LDS_BYTES, stream);
    if (e != hipSuccess) fprintf(stderr, "kernel_launch: cooperative launch failed: %s (grid %d)\n", hipGetErrorString(e), grid);
}
```
